# Optimizing an MI355X kernel written in HIP

```python
import jax, jax.numpy as jnp
from jax import lax
import numpy as np

D_MODEL = 1024
BATCH = 2
SEQ = 8192
DEPTH = 4

CTX_LEN = 256
GRID_W = 64
N_GROUPS = 4
GROUP_W = D_MODEL // N_GROUPS
MIX_W = N_GROUPS * GROUP_W
GLA_HEADS = 4
GLA_DK = GROUP_W // GLA_HEADS
GLA_W = GLA_HEADS * GLA_DK
GLA_GATE_RANK = 16
GLA_TAU = 16.0
GLA_CHUNK = 64
GMLP_GROUPS = 4
GMLP_W = GROUP_W
GMLP_CHUNK = 128
LRU_W = GROUP_W
LRU_BLOCKS = 4
LRU_C = 8.0
CONV_W = 4
NAT_HEADS = 4
NAT_DH = GROUP_W // NAT_HEADS
NAT_W = NAT_HEADS * NAT_DH
NAT_KR_MAX = 8
NAT_KC = 16
NAT_QC = 16
NAT_KB = NAT_QC + NAT_KC
N_EXPERTS = 16
EXPERT_FF = 2 * D_MODEL
EC_CAPACITY = 2
ROPE_BASE = 10000.0
EPS = 1e-6

IN_SIZES = (GLA_W, GLA_W, GLA_W, GLA_W, GLA_GATE_RANK, GLA_GATE_RANK,
            GMLP_W, GMLP_W, LRU_W, LRU_W, NAT_W, NAT_W, NAT_W)
IN_COLS = sum(IN_SIZES)
IN_OFFSETS = tuple(sum(IN_SIZES[:i + 1]) for i in range(len(IN_SIZES) - 1))

kernel_name = "hybrid_gla_gmlp_rglru_natten_ec_moe_dit"


def rms_norm(x, g):
    xf = x.astype(jnp.float32)
    y = xf * lax.rsqrt(jnp.mean(xf * xf, axis=-1, keepdims=True) + EPS)
    return (y * g.astype(jnp.float32)).astype(x.dtype)


def split_heads(t, h):
    return t.reshape(t.shape[0], t.shape[1], h, -1)


def axial_rope(t, n):
    half = t.shape[-1] // 2
    quarter = half // 2
    pos = jnp.arange(n)
    row = (pos // GRID_W).astype(jnp.float32)
    col = (pos % GRID_W).astype(jnp.float32)
    inv = ROPE_BASE ** (-jnp.arange(quarter, dtype=jnp.float32) / quarter)

    def rot(u, p):
        ang = p[:, None] * inv[None, :]
        cos = jnp.cos(ang)[None, :, None, :].astype(u.dtype)
        sin = jnp.sin(ang)[None, :, None, :].astype(u.dtype)
        u1, u2 = u[..., :quarter], u[..., quarter:]
        return jnp.concatenate([u1 * cos - u2 * sin, u1 * sin + u2 * cos], axis=-1)

    return jnp.concatenate([rot(t[..., :half], row), rot(t[..., half:], col)], axis=-1)


def gla_log_decay(z, w, b):
    a = jnp.einsum('blr,rk->blk', z, w) + b
    la = jax.nn.log_sigmoid(a.astype(jnp.float32)) / GLA_TAU
    return la.reshape(z.shape[0], z.shape[1], GLA_HEADS, GLA_DK)


def gla_chunk_scan(q, k, v, la, s0):
    B, L, H, _ = q.shape
    nc = L // GLA_CHUNK

    def blk(t):
        return t.astype(jnp.float32).reshape(B, nc, GLA_CHUNK, H, t.shape[-1]).transpose(1, 0, 3, 2, 4)

    qf, kf, vf, gf = blk(q), blk(k), blk(v), blk(la)
    b = jnp.cumsum(gf, axis=3)
    b_last = b[:, :, :, -1:, :]
    q_in = qf * jnp.exp(b)
    k_in = kf * jnp.exp(-b)
    k_end = kf * jnp.exp(b_last - b)
    mask = jnp.tril(jnp.ones((GLA_CHUNK, GLA_CHUNK), dtype=bool))
    att = jnp.where(mask, jnp.einsum('nbhcd,nbhsd->nbhcs', q_in, k_in), 0.0)
    o_intra = jnp.einsum('nbhcs,nbhse->nbhce', att, vf)
    dec = jnp.exp(b_last)

    def step(S, inp):
        q_i, k_e, v_i, d_i = inp
        o = jnp.einsum('bhcd,bhde->bhce', q_i, S)
        S = S * d_i[:, :, 0, :, None] + jnp.einsum('bhcd,bhce->bhde', k_e, v_i)
        return S, o

    s_fin, o_inter = lax.scan(step, s0.astype(jnp.float32), (q_in, k_end, vf, dec))
    o = (o_intra + o_inter).transpose(1, 0, 3, 2, 4).reshape(B, L, H, -1)
    return o, s_fin


def gla_direction(q, k, v, la, cq, ck, cv, cla, reverse):
    if reverse:
        q, k, v, la, cq, ck, cv, cla = [jnp.flip(t, axis=1) for t in (q, k, v, la, cq, ck, cv, cla)]
    s0 = jnp.zeros((q.shape[0], GLA_HEADS, GLA_DK, GLA_DK), jnp.float32)
    oc, s_ctx = gla_chunk_scan(cq, ck, cv, cla, s0)
    o, _ = gla_chunk_scan(q, k, v, la, s_ctx)
    if reverse:
        o, oc = jnp.flip(o, axis=1), jnp.flip(oc, axis=1)
    return o, oc


def spatial_gate(u, v, norm_g, w_s, b_s):
    B, L, _ = v.shape
    vn = rms_norm(v, norm_g).reshape(B, L // GMLP_CHUNK, GMLP_CHUNK, GMLP_GROUPS, GMLP_W // GMLP_GROUPS)
    mixed = jnp.einsum('gij,bnjgd->bnigd', w_s, vn) + b_s.T[None, None, :, :, None]
    return u * mixed.reshape(B, L, GMLP_W)


def short_conv(x, w, b):
    y = lax.conv_general_dilated(x, w[:, None, :].astype(x.dtype), window_strides=(1,),
                                 padding=[(CONV_W // 2, CONV_W - 1 - CONV_W // 2)],
                                 dimension_numbers=('NWC', 'WIO', 'NWC'),
                                 feature_group_count=x.shape[-1])
    return y + b


def rglru_gates(xc, w_r, b_r, w_i, b_i, lam):
    B, L, _ = xc.shape
    xb = xc.reshape(B, L, LRU_BLOCKS, -1)
    r = jax.nn.sigmoid(jnp.einsum('blgi,gij->blgj', xb, w_r).reshape(B, L, LRU_W) + b_r)
    i = jax.nn.sigmoid(jnp.einsum('blgi,gij->blgj', xb, w_i).reshape(B, L, LRU_W) + b_i)
    log_a = -LRU_C * r.astype(jnp.float32) * jax.nn.softplus(-lam.astype(jnp.float32))
    a = jnp.exp(log_a)
    inp = jnp.sqrt(-jnp.expm1(2.0 * log_a)) * (i * xc).astype(jnp.float32)
    return a, inp


def linear_scan(a, b, h0):
    def comb(x, y):
        return (x[0] * y[0], y[0] * x[1] + y[1])
    A, H = lax.associative_scan(comb, (a, b), axis=1)
    h = H + A * h0[:, None, :]
    return h, h[:, -1]


def rglru_mixer(lx, ly, clx, cly, conv_w, conv_b, w_r, b_r, w_i, b_i, lam):
    xl = short_conv(lx, conv_w, conv_b)
    xc = short_conv(clx, conv_w, conv_b)
    outs_l, outs_c = [], []
    for d in range(2):
        al, bl = rglru_gates(xl, w_r[d], b_r[d], w_i[d], b_i[d], lam[d])
        ac, bc = rglru_gates(xc, w_r[d], b_r[d], w_i[d], b_i[d], lam[d])
        if d == 1:
            al, bl, ac, bc = [jnp.flip(t, axis=1) for t in (al, bl, ac, bc)]
        h0 = jnp.zeros((xl.shape[0], LRU_W), jnp.float32)
        hc, s_ctx = linear_scan(ac, bc, h0)
        hl, _ = linear_scan(al, bl, s_ctx)
        if d == 1:
            hl, hc = jnp.flip(hl, axis=1), jnp.flip(hc, axis=1)
        outs_l.append(hl)
        outs_c.append(hc)
    out_l = (outs_l[0] + outs_l[1]) * jax.nn.gelu(ly)
    out_c = (outs_c[0] + outs_c[1]) * jax.nn.gelu(cly)
    return out_l, out_c


def neighbourhood_attention(q, k, v, kc, vc, rpb):
    B, N, H, Dh = q.shape
    rows = N // GRID_W
    kr = min(NAT_KR_MAX, rows)
    ncb = GRID_W // NAT_QC
    scale = Dh ** -0.5
    r = jnp.arange(rows)
    row_idx = jnp.clip(r - kr // 2, 0, rows - kr)[:, None] + jnp.arange(kr)[None, :]
    band0 = jnp.clip(jnp.arange(ncb) * NAT_QC - NAT_KC // 2, 0, GRID_W - NAT_KB)
    col_idx = band0[:, None] + jnp.arange(NAT_KB)[None, :]
    qcol = jnp.arange(ncb)[:, None] * NAT_QC + jnp.arange(NAT_QC)[None, :]
    col0 = jnp.clip(qcol - NAT_KC // 2, 0, GRID_W - NAT_KC)
    kcol = col_idx[:, None, :]
    valid = (kcol >= col0[..., None]) & (kcol < col0[..., None] + NAT_KC)
    dr = row_idx - r[:, None] + NAT_KR_MAX - 1
    dc = jnp.clip(kcol - qcol[..., None], -(NAT_KC - 1), NAT_KC - 1) + NAT_KC - 1
    bias = rpb[:, dr[:, None, None, :, None], dc[None, :, :, None, :]]
    bias = jnp.moveaxis(bias, 0, 3).astype(jnp.float32)
    qg = q.reshape(B, rows, ncb, NAT_QC, H, Dh)
    gi_r = row_idx[:, None, :, None]
    gi_c = col_idx[None, :, None, :]
    kg = k.reshape(B, rows, GRID_W, H, Dh)[:, gi_r, gi_c]
    vg = v.reshape(B, rows, GRID_W, H, Dh)[:, gi_r, gi_c]
    s_loc = jnp.einsum('brnqhd,brnijhd->brnqhij', qg, kg).astype(jnp.float32) * scale + bias
    s_loc = jnp.where(valid[None, None, :, :, None, None, :], s_loc, -jnp.inf)
    s_loc = s_loc.reshape(B, rows, ncb, NAT_QC, H, kr * NAT_KB)
    s_ctx = jnp.einsum('brnqhd,bmhd->brnqhm', qg, kc).astype(jnp.float32) * scale
    p = jax.nn.softmax(jnp.concatenate([s_loc, s_ctx], axis=-1), axis=-1).astype(v.dtype)
    p_loc = p[..., :kr * NAT_KB].reshape(B, rows, ncb, NAT_QC, H, kr, NAT_KB)
    p_ctx = p[..., kr * NAT_KB:]
    o = jnp.einsum('brnqhij,brnijhd->brnqhd', p_loc, vg) + jnp.einsum('brnqhm,bmhd->brnqhd', p_ctx, vc)
    return o.reshape(B, N, H * Dh)


def context_attention(q, k, v):
    B, M, H, Dh = q.shape
    s = jnp.einsum('bmhd,bnhd->bhmn', q, k).astype(jnp.float32) * (Dh ** -0.5)
    p = jax.nn.softmax(s, axis=-1).astype(v.dtype)
    return jnp.einsum('bhmn,bnhd->bmhd', p, v).reshape(B, M, H * Dh)


def token_mixer(h, hc, w_in, gla_w_gate, gla_b_gate, gla_norm_g, gmlp_norm_g, gmlp_w_s, gmlp_b_s,
                lru_conv_w, lru_conv_b, lru_w_r, lru_b_r, lru_w_i, lru_b_i, lru_lambda, nat_rpb, need_ctx):
    B, N, _ = h.shape
    M = hc.shape[1]
    q, k, v, og, glf, glb, gu, gv, lx, ly, nq, nk, nv = jnp.split(h @ w_in, IN_OFFSETS, axis=-1)
    cq, ck, cv, cog, cglf, cglb, cgu, cgv, clx, cly, cnq, cnk, cnv = jnp.split(hc @ w_in, IN_OFFSETS, axis=-1)

    gq = axial_rope(split_heads(q, GLA_HEADS), N) * (GLA_DK ** -0.5)
    gk = axial_rope(split_heads(k, GLA_HEADS), N)
    gv_ = split_heads(v, GLA_HEADS)
    gcq = split_heads(cq, GLA_HEADS) * (GLA_DK ** -0.5)
    gck = split_heads(ck, GLA_HEADS)
    gcv = split_heads(cv, GLA_HEADS)
    o_dirs, oc_dirs = [], []
    for d, (gl, cgl) in enumerate(((glf, cglf), (glb, cglb))):
        la = gla_log_decay(gl, gla_w_gate[d], gla_b_gate[d])
        cla = gla_log_decay(cgl, gla_w_gate[d], gla_b_gate[d])
        o, oc = gla_direction(gq, gk, gv_, la, gcq, gck, gcv, cla, reverse=(d == 1))
        o_dirs.append(o)
        oc_dirs.append(oc)
    gla_out = rms_norm(o_dirs[0] + o_dirs[1], gla_norm_g).reshape(B, N, GLA_W) * jax.nn.silu(og)

    gmlp_out = spatial_gate(gu, gv, gmlp_norm_g, gmlp_w_s, gmlp_b_s)

    lru_out, lru_ctx = rglru_mixer(lx, ly, clx, cly, lru_conv_w, lru_conv_b,
                                   lru_w_r, lru_b_r, lru_w_i, lru_b_i, lru_lambda)

    nck = split_heads(cnk, NAT_HEADS)
    ncv = split_heads(cnv, NAT_HEADS)
    nat_out = neighbourhood_attention(split_heads(nq, NAT_HEADS), split_heads(nk, NAT_HEADS),
                                      split_heads(nv, NAT_HEADS), nck, ncv, nat_rpb)

    mix = jnp.concatenate([gla_out.astype(h.dtype), gmlp_out.astype(h.dtype),
                           lru_out.astype(h.dtype), nat_out.astype(h.dtype)], axis=-1)
    if not need_ctx:
        return mix, None
    gla_c = rms_norm(oc_dirs[0] + oc_dirs[1], gla_norm_g).reshape(B, M, GLA_W) * jax.nn.silu(cog)
    gmlp_c = spatial_gate(cgu, cgv, gmlp_norm_g, gmlp_w_s, gmlp_b_s)
    nat_c = context_attention(split_heads(cnq, NAT_HEADS), nck, ncv)
    mix_c = jnp.concatenate([gla_c.astype(hc.dtype), gmlp_c.astype(hc.dtype),
                             lru_ctx.astype(hc.dtype), nat_c.astype(hc.dtype)], axis=-1)
    return mix, mix_c


def expert_choice_ffn(h, w_router, w_gate, w_up, w_down):
    B, n, _ = h.shape
    cap = max(1, EC_CAPACITY * n // N_EXPERTS)
    aff = jax.nn.softmax(jnp.einsum('bnd,de->bne', h, w_router).astype(jnp.float32), axis=-1)
    g, idx = lax.top_k(jnp.swapaxes(aff, 1, 2), cap)
    bi = jnp.arange(B)[:, None, None]
    xs = h[bi, idx]
    hid = jax.nn.silu(jnp.einsum('becd,edf->becf', xs, w_gate)) * jnp.einsum('becd,edf->becf', xs, w_up)
    y = jnp.einsum('becf,efd->becd', hid, w_down) * g[..., None].astype(h.dtype)
    return jnp.zeros_like(h).at[bi, idx].add(y)


def setup_inputs(seed: int = 0) -> dict:
    key = jax.random.key(seed)
    ks = jax.random.split(key, 32)
    f32 = jnp.float32
    L = DEPTH

    def nrm(k, shape, scale):
        return jax.random.normal(k, shape, f32) * scale

    u = jax.random.uniform(ks[22], (L, 2, LRU_W), f32, 0.9, 0.999)
    a0 = u ** (1.0 / LRU_C)
    lru_lambda = jnp.log(a0) - jnp.log1p(-a0)
    hd = LRU_W // LRU_BLOCKS
    return {
        "x": nrm(ks[0], (BATCH, SEQ, D_MODEL), 1.0),
        "c": nrm(ks[1], (BATCH, D_MODEL), 1.0),
        "ctx": nrm(ks[2], (BATCH, CTX_LEN, D_MODEL), 1.0),
        "c_ctx": nrm(ks[3], (D_MODEL,), 1.0),
        "w_ada": nrm(ks[4], (L, D_MODEL, 6 * D_MODEL), 0.5 * D_MODEL ** -0.5),
        "b_ada": nrm(ks[5], (L, 6 * D_MODEL), 0.02),
        "norm1_g": 1.0 + nrm(ks[6], (L, D_MODEL), 0.02),
        "norm2_g": 1.0 + nrm(ks[7], (L, D_MODEL), 0.02),
        "w_in": nrm(ks[8], (L, D_MODEL, IN_COLS), D_MODEL ** -0.5),
        "w_out": nrm(ks[9], (L, MIX_W, D_MODEL), MIX_W ** -0.5),
        "gla_w_gate": nrm(ks[10], (L, 2, GLA_GATE_RANK, GLA_W), GLA_GATE_RANK ** -0.5),
        "gla_b_gate": nrm(ks[11], (L, 2, GLA_W), 0.1),
        "gla_norm_g": 1.0 + nrm(ks[12], (L, GLA_DK), 0.02),
        "gmlp_norm_g": 1.0 + nrm(ks[13], (L, GMLP_W), 0.02),
        "gmlp_w_s": nrm(ks[14], (L, GMLP_GROUPS, GMLP_CHUNK, GMLP_CHUNK), GMLP_CHUNK ** -0.5),
        "gmlp_b_s": nrm(ks[15], (L, GMLP_GROUPS, GMLP_CHUNK), 0.02),
        "lru_conv_w": nrm(ks[16], (L, CONV_W, LRU_W), CONV_W ** -0.5),
        "lru_conv_b": nrm(ks[17], (L, LRU_W), 0.02),
        "lru_w_r": nrm(ks[18], (L, 2, LRU_BLOCKS, hd, hd), hd ** -0.5),
        "lru_b_r": nrm(ks[19], (L, 2, LRU_W), 0.02),
        "lru_w_i": nrm(ks[20], (L, 2, LRU_BLOCKS, hd, hd), hd ** -0.5),
        "lru_b_i": nrm(ks[21], (L, 2, LRU_W), 0.02),
        "lru_lambda": lru_lambda,
        "nat_rpb": nrm(ks[23], (L, NAT_HEADS, 2 * NAT_KR_MAX - 1, 2 * NAT_KC - 1), 0.1),
        "moe_w_router": nrm(ks[24], (L, D_MODEL, N_EXPERTS), D_MODEL ** -0.5),
        "moe_w_gate": nrm(ks[25], (L, N_EXPERTS, D_MODEL, EXPERT_FF), D_MODEL ** -0.5),
        "moe_w_up": nrm(ks[26], (L, N_EXPERTS, D_MODEL, EXPERT_FF), D_MODEL ** -0.5),
        "moe_w_down": nrm(ks[27], (L, N_EXPERTS, EXPERT_FF, D_MODEL), EXPERT_FF ** -0.5),
        "final_norm_g": 1.0 + nrm(ks[28], (D_MODEL,), 0.02),
    }


def reference(x, c, ctx, c_ctx, w_ada, b_ada, norm1_g, norm2_g, w_in, w_out, gla_w_gate, gla_b_gate,
              gla_norm_g, gmlp_norm_g, gmlp_w_s, gmlp_b_s, lru_conv_w, lru_conv_b, lru_w_r, lru_b_r,
              lru_w_i, lru_b_i, lru_lambda, nat_rpb, moe_w_router, moe_w_gate, moe_w_up, moe_w_down,
              final_norm_g):
    sc = jax.nn.silu(c)
    scc = jax.nn.silu(c_ctx)
    xc = ctx
    for l in range(DEPTH):
        need_ctx = l < DEPTH - 1
        mod = sc @ w_ada[l] + b_ada[l]
        mod_c = scc @ w_ada[l] + b_ada[l]
        sh1, sc1, g1, sh2, sc2, g2 = jnp.split(mod[:, None, :], 6, axis=-1)
        csh1, csc1, cg1, csh2, csc2, cg2 = jnp.split(mod_c, 6, axis=-1)
        h = rms_norm(x, norm1_g[l]) * (1.0 + sc1) + sh1
        hc = rms_norm(xc, norm1_g[l]) * (1.0 + csc1) + csh1
        mix, mix_c = token_mixer(h, hc, w_in[l], gla_w_gate[l], gla_b_gate[l], gla_norm_g[l],
                                 gmlp_norm_g[l], gmlp_w_s[l], gmlp_b_s[l], lru_conv_w[l], lru_conv_b[l],
                                 lru_w_r[l], lru_b_r[l], lru_w_i[l], lru_b_i[l], lru_lambda[l], nat_rpb[l],
                                 need_ctx)
        x = x + g1 * (mix @ w_out[l])
        h2 = rms_norm(x, norm2_g[l]) * (1.0 + sc2) + sh2
        x = x + g2 * expert_choice_ffn(h2, moe_w_router[l], moe_w_gate[l], moe_w_up[l], moe_w_down[l])
        if need_ctx:
            xc = xc + cg1 * (mix_c @ w_out[l])
            hc2 = rms_norm(xc, norm2_g[l]) * (1.0 + csc2) + csh2
            xc = xc + cg2 * expert_choice_ffn(hc2, moe_w_router[l], moe_w_gate[l], moe_w_up[l], moe_w_down[l])
    return rms_norm(x, final_norm_g)
```

```cpp
#include <hip/hip_runtime.h>
#include <cstdio>
#include <cstdint>

#define LAS __attribute__((address_space(3)))
#define GAS __attribute__((address_space(1)))
typedef unsigned short bf16_t;
typedef short bf16x8 __attribute__((ext_vector_type(8)));
typedef float f32x4 __attribute__((ext_vector_type(4)));
typedef float f32x2 __attribute__((ext_vector_type(2)));
typedef unsigned u32x4 __attribute__((ext_vector_type(4)));
typedef unsigned u32x2 __attribute__((ext_vector_type(2)));

#ifndef REP_P0
#define REP_P0 1
#endif
#ifndef REP_MIX
#define REP_MIX 1
#endif
#ifndef REP_GLA
#define REP_GLA 1
#endif
#ifndef REP_NAT
#define REP_NAT 1
#endif
#ifndef PROBE_DRY
#define PROBE_DRY 0
#endif
#ifndef PROBE_BAR
#define PROBE_BAR 0
#endif
#ifndef REP_LRU
#define REP_LRU 1
#endif
#ifndef REP_GMLP
#define REP_GMLP 1
#endif
#ifndef REP_P5
#define REP_P5 1
#endif
#ifndef REP_SMALL
#define REP_SMALL 1
#endif
#ifndef REP_GEMM
#define REP_GEMM 1
#endif
#ifndef MK_SINGLE
#define MK_SINGLE 1
#endif

constexpr int D = 1024, NB = 2, SEQ = 8192, CTX = 256, DEPTH = 4;
constexpr int NLAT = NB * SEQ, NCTXR = NB * CTX, MROWS = NLAT + NCTXR;
constexpr int INC = 2848, PC = 2816;
constexpr int C_Q = 0, C_K = 256, C_V = 512, C_OG = 768, C_GU = 1024, C_GV = 1280, C_LX = 1536, C_LY = 1792, C_NQ = 2048, C_NK = 2304, C_NV = 2560;
constexpr int NE = 16, FF = 2048;
constexpr int XS_PER_E = 2304, XS_ROWS = NE * XS_PER_E;
constexpr int NCH = 132;
constexpr float EPS = 1e-6f;

constexpr size_t MiB = 1u << 20;
constexpr size_t al256(size_t x) { return (x + 255) & ~(size_t)255; }
constexpr size_t WS_CTL = 0, CTL_BYTES = 1 * MiB;
constexpr size_t WS_MODP = WS_CTL + CTL_BYTES;
constexpr size_t WS_MOD = WS_MODP + al256((size_t)DEPTH * 8 * 3 * 6144 * 4);
constexpr size_t WS_WIN = WS_MOD + al256((size_t)DEPTH * 3 * 6144 * 4);
constexpr size_t WS_WOUT = WS_WIN + al256((size_t)DEPTH * INC * D * 2);
constexpr size_t WS_W1 = WS_WOUT + al256((size_t)DEPTH * D * D * 2);
constexpr size_t WS_W2 = WS_W1 + al256((size_t)DEPTH * NE * 4096 * D * 2);
constexpr size_t WS_X = WS_W2 + al256((size_t)DEPTH * NE * D * FF * 2);
constexpr size_t WS_H = WS_X + al256((size_t)MROWS * D * 4);
constexpr size_t WS_P = WS_H + al256((size_t)MROWS * D * 2);
constexpr size_t WS_Z = WS_P + al256((size_t)MROWS * PC * 2);
constexpr size_t WS_MIX = WS_Z + al256((size_t)MROWS * 32 * 4);
constexpr size_t WS_KV = WS_MIX + al256((size_t)MROWS * D * 2);
constexpr size_t WS_DEC = WS_KV + al256((size_t)2 * 2 * 4 * NCH * 4096 * 4);
constexpr size_t WS_LH = WS_DEC + al256((size_t)2 * 2 * 4 * NCH * 64 * 4);
constexpr size_t WS_LA = WS_LH + al256((size_t)2 * MROWS * 256 * 4);
constexpr size_t WS_LSA = WS_LA + al256((size_t)2 * MROWS * 256 * 4);
constexpr size_t WS_LSH = WS_LSA + al256((size_t)2 * 2 * NCH * 256 * 4);
constexpr size_t WS_LC = WS_LSH + al256((size_t)2 * 2 * NCH * 256 * 4);
constexpr size_t WS_AFF = WS_LC + al256((size_t)2 * 2 * NCH * 256 * 4);
constexpr size_t WS_SLOT = WS_AFF + al256((size_t)(2 * 16 * 8192 + 2 * 16 * 256) * 4);
constexpr size_t WS_GSEL = WS_SLOT + al256((size_t)(2 * 16 * 8192 + 2 * 16 * 256) * 4);
constexpr size_t WS_XS = WS_GSEL + al256((size_t)XS_ROWS * 4);
constexpr size_t WS_HID = WS_XS + al256((size_t)XS_ROWS * D * 2);
constexpr size_t WS_Y = WS_HID + al256((size_t)XS_ROWS * FF * 2);
constexpr size_t WS_LRUW = WS_Y + al256((size_t)XS_ROWS * D * 2);
constexpr size_t WS_ROPE = WS_LRUW + al256((size_t)DEPTH * 16 * 4096 * 2);
constexpr size_t WS_OI = WS_ROPE + al256((size_t)128 * 16 * 2 * 4);
constexpr size_t WS_QIG = WS_OI + al256((size_t)2 * NCH * 4 * 4 * 64 * 16 * 4);
constexpr size_t WS_SS = WS_QIG + al256((size_t)2 * NCH * 4 * 2 * 4 * 64 * 16 * 2);
constexpr size_t WS_Y2 = WS_SS + al256((size_t)16 * NCH * 4096 * 2);
constexpr size_t WS_END = WS_Y2 + al256((size_t)NE * 256 * D * 2);

constexpr int LDS_BYTES = 163840;
constexpr int LDS_MISC = 163840 - 256;
constexpr int NWAVES = 8;

__device__ __forceinline__ float bf2f(unsigned b) { return __uint_as_float(b << 16); }
typedef __bf16 bf16x2_t __attribute__((ext_vector_type(2)));
__device__ __forceinline__ unsigned pk2(float lo, float hi) { const f32x2 v = {lo, hi}; return __builtin_bit_cast(unsigned, __builtin_convertvector(v, bf16x2_t)); }
__device__ __forceinline__ unsigned f2bf(float f) { return pk2(f, 0.f) & 0xffffu; }
__device__ __forceinline__ float wave_sum(float v) {
    v += __int_as_float(__builtin_amdgcn_update_dpp(0, __float_as_int(v), 0xB1, 0xf, 0xf, true));
    v += __int_as_float(__builtin_amdgcn_update_dpp(0, __float_as_int(v), 0x4E, 0xf, 0xf, true));
    v += __int_as_float(__builtin_amdgcn_update_dpp(0, __float_as_int(v), 0x124, 0xf, 0xf, true));
    v += __int_as_float(__builtin_amdgcn_update_dpp(0, __float_as_int(v), 0x128, 0xf, 0xf, true));
    const int iv = __float_as_int(v);
    return (__int_as_float(__builtin_amdgcn_readlane(iv, 0)) + __int_as_float(__builtin_amdgcn_readlane(iv, 16))) + (__int_as_float(__builtin_amdgcn_readlane(iv, 32)) + __int_as_float(__builtin_amdgcn_readlane(iv, 48)));
}
__device__ __forceinline__ float wave_max(float v) {
#pragma unroll
    for (int o = 1; o < 64; o <<= 1) v = fmaxf(v, __shfl_xor(v, o));
    return v;
}
template <class T> __device__ __forceinline__ void pin1(T& a) { asm volatile("" : "+v"(a) :: "memory"); }
template <class T> __device__ __forceinline__ void pin2(T (&x)[2]) { asm volatile("" : "+v"(x[0]), "+v"(x[1]) :: "memory"); }
template <class T> __device__ __forceinline__ void pin4(T (&x)[4]) { asm volatile("" : "+v"(x[0]), "+v"(x[1]), "+v"(x[2]), "+v"(x[3]) :: "memory"); }
template <class T> __device__ __forceinline__ void pin6(T (&x)[6]) { asm volatile("" : "+v"(x[0]), "+v"(x[1]), "+v"(x[2]), "+v"(x[3]), "+v"(x[4]), "+v"(x[5]) :: "memory"); }
template <class T> __device__ __forceinline__ void pin8(T (&x)[8]) { asm volatile("" : "+v"(x[0]), "+v"(x[1]), "+v"(x[2]), "+v"(x[3]), "+v"(x[4]), "+v"(x[5]), "+v"(x[6]), "+v"(x[7]) :: "memory"); }
template <class T> __device__ __forceinline__ void pin12(T (&x)[12]) { asm volatile("" : "+v"(x[0]), "+v"(x[1]), "+v"(x[2]), "+v"(x[3]), "+v"(x[4]), "+v"(x[5]), "+v"(x[6]), "+v"(x[7]), "+v"(x[8]), "+v"(x[9]), "+v"(x[10]), "+v"(x[11]) :: "memory"); }
template <class T> __device__ __forceinline__ void pin16(T (&x)[16]) { asm volatile("" : "+v"(x[0]), "+v"(x[1]), "+v"(x[2]), "+v"(x[3]), "+v"(x[4]), "+v"(x[5]), "+v"(x[6]), "+v"(x[7]),
                                                                                    "+v"(x[8]), "+v"(x[9]), "+v"(x[10]), "+v"(x[11]), "+v"(x[12]), "+v"(x[13]), "+v"(x[14]), "+v"(x[15]) :: "memory"); }
__device__ __forceinline__ float sigmoidf_(float x) { return 1.0f / (1.0f + expf(-x)); }
__device__ __forceinline__ float siluf_(float x) { return x / (1.0f + expf(-x)); }
__device__ __forceinline__ float softplusf_(float x) { return fmaxf(x, 0.f) + log1pf(expf(-fabsf(x))); }
__device__ __forceinline__ float logsigmoidf_(float x) { return -softplusf_(-x); }
__device__ __forceinline__ float gelu_tanh(float x) { const float u = 0.7978845608028654f * (x + 0.044715f * x * x * x); return x * __builtin_amdgcn_rcpf(1.0f + __expf(-2.0f * u)); }
__device__ __forceinline__ float silu_fast(float x) { return x * __builtin_amdgcn_rcpf(1.0f + __expf(-x)); }
__device__ __forceinline__ float logsigmoid_fast(float x) { return fminf(x, 0.f) - __logf(1.0f + __expf(-fabsf(x))); }
#define LDS_WAIT() asm volatile("s_waitcnt lgkmcnt(0)" ::: "memory")
__device__ __forceinline__ float rope_inv(int a) { return powf(10000.0f, -(float)a / 16.0f); }

#define XB_TMO      128
#define XB_XCNT(j)  (256  + 64 * (j))
#define XB_XSUB(j)  (1280 + 64 * (j))
#define XB_XGEN(j)  (2304 + 64 * (j))
#define XB_TOP      3328
#define XB_TOPGEN   3392
#define XCD_BAR_WORDS 3456
#define XB_SPIN_CAP (1u << 18)
__device__ __forceinline__ unsigned xb_ld(unsigned* p)              { return __hip_atomic_load(p, __ATOMIC_RELAXED, __HIP_MEMORY_SCOPE_AGENT); }
__device__ __forceinline__ unsigned xb_add(unsigned* p, unsigned v) { return __hip_atomic_fetch_add(p, v, __ATOMIC_RELAXED, __HIP_MEMORY_SCOPE_AGENT); }
__device__ __forceinline__ unsigned xb_xcc_id() { return (unsigned)__builtin_amdgcn_s_getreg((3 << 11) | 20) & 0xFu; }
#define XB_SPIN(cond, bar) do { unsigned _sp = 0; while (cond) { __builtin_amdgcn_s_sleep(1); \
    if ((++_sp & 255u) == 0u) { if (xb_ld(&(bar)[XB_TMO])) break; if (_sp > XB_SPIN_CAP) { atomicAdd(&(bar)[XB_TMO], 1u); break; } } } } while (0)
struct XcdBarrier { unsigned* bar; unsigned x; volatile LAS unsigned* st; };
__device__ __forceinline__ XcdBarrier xcd_barrier_post(unsigned* bar, volatile LAS unsigned* st) {
    XcdBarrier b; b.bar = bar; b.x = xb_xcc_id(); b.st = st;
    if (threadIdx.x == 0) (void)xb_add(&bar[XB_XCNT(b.x)], 1u);
    return b;
}
__device__ __forceinline__ void xcd_barrier_complete(unsigned* bar, unsigned x, unsigned& nloc, unsigned& nx) {
    const unsigned G = gridDim.x * gridDim.y * gridDim.z;
    unsigned sum, cnt, mine, sp = 0u;
    for (;;) {
        sum = 0u; cnt = 0u; mine = 0u;
#pragma unroll
        for (unsigned j = 0; j < 16; ++j) { const unsigned c = xb_ld(&bar[XB_XCNT(j)]); sum += c; cnt += (c > 0u) ? 1u : 0u; mine = (j == x) ? c : mine; }
        if (sum == G) break;
        __builtin_amdgcn_s_sleep(1);
        if ((++sp & 255u) == 0u) { if (xb_ld(&bar[XB_TMO])) break; if (sp > XB_SPIN_CAP) { atomicAdd(&bar[XB_TMO], 1u); break; } }
    }
    nloc = mine > 0u ? mine : 1u; nx = cnt > 0u ? cnt : 1u;
}
__device__ __forceinline__ void xcd_barrier(const XcdBarrier& b) {
    asm volatile("s_waitcnt vmcnt(0)" ::: "memory");
    __syncthreads();
    if (threadIdx.x == 0) {
        unsigned* bar = b.bar;
        __builtin_amdgcn_s_waitcnt(0);
        unsigned nloc = b.st[0], nx = b.st[1];
        if (nloc == 0u) { xcd_barrier_complete(bar, b.x, nloc, nx); b.st[0] = nloc; b.st[1] = nx; }
        const unsigned old = xb_add(&bar[XB_XSUB(b.x)], 1u);
        const unsigned gen = old / nloc;
        if (old + 1u == (gen + 1u) * nloc) {
            __builtin_amdgcn_fence(__ATOMIC_RELEASE, "agent");
            asm volatile("s_waitcnt vmcnt(0)" ::: "memory");
            const unsigned og = xb_add(&bar[XB_TOP], 1u);
            const unsigned tg = og / nx;
            if (og + 1u == (tg + 1u) * nx) xb_add(&bar[XB_TOPGEN], 1u);
            else XB_SPIN(xb_ld(&bar[XB_TOPGEN]) == tg, bar);
            __builtin_amdgcn_fence(__ATOMIC_ACQUIRE, "agent");
            xb_add(&bar[XB_XGEN(b.x)], 1u);
            asm volatile("s_waitcnt vmcnt(0)" ::: "memory");
        } else {
            XB_SPIN(xb_ld(&bar[XB_XGEN(b.x)]) == gen, bar);
            __builtin_amdgcn_fence(__ATOMIC_ACQUIRE, "agent");
            asm volatile("s_waitcnt vmcnt(0)" ::: "memory");
        }
    }
    __syncthreads();
}

namespace pg8 {
constexpr int BM = 256, BK = 64, HALF = 128, HTB = HALF * BK * 2, STAGE_BYTES = 8 * HTB, NXCD = 8, WGM = 8;
__host__ __device__ __forceinline__ int lds_byte(int r, int c) { const int st = (r >> 4) * 2 + (c >> 5), rr = r & 15, cc = c & 31, ob = rr * 64 + cc * 2; return st * 1024 + (ob ^ (((ob >> 9) & 1) << 5)); }
__host__ __device__ __forceinline__ void stage_rc(int b, int& R, int& C) { const int st = b / 1024, sb = b % 1024, swz = sb ^ (((sb >> 9) & 1) << 5); R = (st >> 1) * 16 + swz / 64; C = (st & 1) * 32 + (swz % 64) / 2; }
__host__ __device__ __forceinline__ int perm32(int rho) { const int n = rho >> 4, i = rho & 15; return 8 * (i >> 2) + 4 * n + (i & 3); }

struct Unit { int pm, pn, po, kh; };
struct Gemm { const bf16_t* A; const bf16_t* Bt; int K; };

struct StaticOrder {
    static constexpr bool SPLITK = false;
    int nM, nN, nwg, G, c;
    __device__ __forceinline__ void init(int M, int N, int G_, int c_) { nM = M / BM; nN = N / BM; nwg = nM * nN; G = G_; c = c_; }
    __device__ __forceinline__ bool next(int i, Unit& u) const {
        const long L = (long)i * G + c; if (L >= nwg) return false;
        int wgid = (int)L; { const int q = nwg / NXCD, r = nwg % NXCD, xcd = wgid % NXCD, off = wgid / NXCD; wgid = (xcd < r ? xcd * (q + 1) : r * (q + 1) + (xcd - r) * q) + off; }
        const int nig = WGM * nN, gid = wgid / nig, fm = gid * WGM, gsz = (nM - fm) < WGM ? (nM - fm) : WGM;
        u.pm = fm + ((wgid % nig) % gsz); u.pn = (wgid % nig) / gsz; u.po = u.pn; u.kh = -1; return true;
    }
};
struct MoeOrder {
    static constexpr bool SPLITK = false;
    int ppe, nN, nun, G, c;
    __device__ __forceinline__ void init(int ppe_, int nN_, int G_, int vcu) { ppe = ppe_; nN = nN_; nun = NE * ppe_ * nN_; G = G_; c = vcu; }
    __device__ __forceinline__ bool next(int i, Unit& u) const {
        const int L = i * G + c; if (L >= nun) return false;
        const int per = ppe * nN, e = L / per, r = L % per, pl = r % ppe, pn = r / ppe;
        u.pm = e * 9 + pl; u.pn = e * nN + pn; u.po = pn; u.kh = -1; return true;
    }
};
struct MoeOrder2K {
    static constexpr bool SPLITK = true;
    int nlat, nun, G, c;
    __device__ __forceinline__ void init(bool ctx, int G_, int vcu) { nlat = NE * 8 * 4; nun = nlat + (ctx ? NE * 4 * 2 : 0); G = G_; c = vcu; }
    __device__ __forceinline__ bool next(int i, Unit& u) const {
        const int L = i * G + c; if (L >= nun) return false;
        if (L < nlat) { const int e = L >> 5, r = L & 31, pl = r & 7, pn = r >> 3; u.pm = e * 9 + pl; u.pn = e * 4 + pn; u.po = pn; u.kh = -1; }
        else { const int q = L - nlat, e = q >> 3, r = q & 7, pn = r & 3; u.pm = e * 9 + 8; u.pn = e * 4 + pn; u.po = pn; u.kh = r >> 2; }
        return true;
    }
};

__device__ __forceinline__ unsigned cvt_pk_bf16(float lo, float hi) { return pk2(lo, hi); }

struct EpiBf16 {
    static constexpr bool PERM = true;
    bf16_t* O; int ldc; bf16_t* O2 = nullptr;
    __device__ __forceinline__ void operator()(const f32x4 (&acc)[2][2][4][2], const Unit& u, int wr, int wc, int fr, int fq) const {
        const bool second = u.kh == 1;
        bf16_t* const O = second ? this->O2 : this->O;
        const int row0 = (second ? u.pm / 9 : u.pm) * BM + wr * 64 + fr, col0 = u.po * BM + wc * 32 + 8 * fq;
#pragma unroll
        for (int ai = 0; ai < 2; ++ai)
#pragma unroll
            for (int m = 0; m < 4; ++m) { bf16_t* rowp = O + (size_t)(row0 + ai * HALF + m * 16) * ldc + col0;
#pragma unroll
                for (int bj = 0; bj < 2; ++bj) { const f32x4 v0 = acc[ai][bj][m][0], v1 = acc[ai][bj][m][1];
                    u32x4 w; w.x = cvt_pk_bf16(v0[0], v0[1]); w.y = cvt_pk_bf16(v0[2], v0[3]); w.z = cvt_pk_bf16(v1[0], v1[1]); w.w = cvt_pk_bf16(v1[2], v1[3]);
                    *(u32x4*)(rowp + bj * HALF) = w; } }
    }
};
struct EpiSwiglu {
    static constexpr bool PERM = true;
    bf16_t* O; int ldc;
    __device__ __forceinline__ void operator()(const f32x4 (&acc)[2][2][4][2], const Unit& u, int wr, int wc, int fr, int fq) const {
        const int row0 = u.pm * BM + wr * 64 + fr, col0 = u.po * HALF + wc * 32 + 8 * fq;
#pragma unroll
        for (int ai = 0; ai < 2; ++ai)
#pragma unroll
            for (int m = 0; m < 4; ++m) { bf16_t* rowp = O + (size_t)(row0 + ai * HALF + m * 16) * ldc + col0;
                float h[8];
#pragma unroll
                for (int n = 0; n < 2; ++n)
#pragma unroll
                    for (int j = 0; j < 4; ++j) { const float g = acc[ai][0][m][n][j], up = acc[ai][1][m][n][j];
                        h[n * 4 + j] = g * __builtin_amdgcn_rcpf(1.0f + __expf(-g)) * up; }
                u32x4 w; w.x = cvt_pk_bf16(h[0], h[1]); w.y = cvt_pk_bf16(h[2], h[3]); w.z = cvt_pk_bf16(h[4], h[5]); w.w = cvt_pk_bf16(h[6], h[7]);
                *(u32x4*)rowp = w; }
    }
};
struct EpiResGate {
    static constexpr bool PERM = true;
    bf16_t* X; const float* modl;
    __device__ __forceinline__ void operator()(const f32x4 (&acc)[2][2][4][2], const Unit& u, int wr, int wc, int fr, int fq) const {
        const int row0 = u.pm * BM + wr * 64 + fr, col0 = u.po * BM + wc * 32 + 8 * fq;
        const int ms = u.pm < 32 ? 0 : (u.pm < 64 ? 1 : 2);
        const float* gp = modl + ms * 6144 + 2048 + col0;
        f32x4 gv[2][2];
#pragma unroll
        for (int bj = 0; bj < 2; ++bj)
#pragma unroll
            for (int n = 0; n < 2; ++n) gv[bj][n] = *(const f32x4*)(gp + bj * HALF + n * 4);
#pragma unroll
        for (int ai = 0; ai < 2; ++ai) {
            bf16_t* rowp = X + (size_t)(row0 + ai * HALF) * D + col0;
            u32x4 xv[8];
#pragma unroll
            for (int m = 0; m < 4; ++m)
#pragma unroll
                for (int bj = 0; bj < 2; ++bj) xv[m * 2 + bj] = *(const u32x4*)(rowp + (size_t)m * 16 * D + bj * HALF);
            asm volatile("" : "+v"(xv[0]), "+v"(xv[1]), "+v"(xv[2]), "+v"(xv[3]), "+v"(xv[4]), "+v"(xv[5]), "+v"(xv[6]), "+v"(xv[7]) :: "memory");
#pragma unroll
            for (int m = 0; m < 4; ++m)
#pragma unroll
                for (int bj = 0; bj < 2; ++bj) { const u32x4 x = xv[m * 2 + bj]; const f32x4 a0 = acc[ai][bj][m][0], a1 = acc[ai][bj][m][1], g0 = gv[bj][0], g1 = gv[bj][1];
                    u32x4 w;
                    w.x = cvt_pk_bf16(__uint_as_float(x.x << 16) + g0[0] * a0[0], __uint_as_float(x.x & 0xffff0000u) + g0[1] * a0[1]);
                    w.y = cvt_pk_bf16(__uint_as_float(x.y << 16) + g0[2] * a0[2], __uint_as_float(x.y & 0xffff0000u) + g0[3] * a0[3]);
                    w.z = cvt_pk_bf16(__uint_as_float(x.z << 16) + g1[0] * a1[0], __uint_as_float(x.z & 0xffff0000u) + g1[1] * a1[1]);
                    w.w = cvt_pk_bf16(__uint_as_float(x.w << 16) + g1[2] * a1[2], __uint_as_float(x.w & 0xffff0000u) + g1[3] * a1[3]);
                    *(u32x4*)(rowp + (size_t)m * 16 * D + bj * HALF) = w; }
        }
    }
};

template <class Epi, class Sched>
__device__ __forceinline__ void gemm_phase(LAS unsigned char* lds, const int tid, const Gemm g, const Sched& S, const Epi& E) {
    const int wid = __builtin_amdgcn_readfirstlane(tid >> 6), lane = tid & 63, wr = wid >> 2, wc = wid & 3, fr = lane & 15, fq = lane >> 4;
    const int K = g.K, nt = K / BK;
    unsigned voffA[2], voffB[2];
#pragma unroll
    for (int i = 0; i < 2; ++i) { int R, C; stage_rc(tid * 16 + i * 8192, R, C); const int Rb = Epi::PERM ? ((R & ~31) + perm32(R & 31)) : R;
        voffA[i] = (unsigned)(R * K + C) * 2u; voffB[i] = (unsigned)(Rb * K + C) * 2u; }
    const size_t kstep = (size_t)(BK * 2);
    const size_t hstep = (size_t)HALF * K * 2;
    const size_t tstep = 2 * hstep;
    const unsigned ldsw = (unsigned)wid * 1024u;
    const int aoff = lds_byte(wr * 64 + fr, fq * 8), boff = lds_byte(wc * 32 + fr, fq * 8);
#define PG8_SA(b, h) (((b) * 2 + (h)) * HTB)
#define PG8_SB(b, h) ((4 + (b) * 2 + (h)) * HTB)
#define PG8_STAGE(bufoff, gbase, voff) do { _Pragma("unroll") for (int _i = 0; _i < 2; ++_i) \
        __builtin_amdgcn_global_load_lds((const unsigned*)((const char*)(gbase) + (voff)[_i]), (LAS unsigned*)(lds + (bufoff) + ldsw + _i * 8192), 16, 0, 0); } while (0)
#define PG8_LDA(dst, b, h) do { _Pragma("unroll") for (int m = 0; m < 4; ++m) _Pragma("unroll") for (int k = 0; k < 2; ++k) dst[m][k] = *(const LAS bf16x8*)(lds + PG8_SA(b, h) + aoff + m * 2048 + k * 1024); } while (0)
#define PG8_LDB(dst, b, h) do { _Pragma("unroll") for (int n = 0; n < 2; ++n) _Pragma("unroll") for (int k = 0; k < 2; ++k) dst[n][k] = *(const LAS bf16x8*)(lds + PG8_SB(b, h) + boff + n * 2048 + k * 1024); } while (0)
#define PG8_MMA(ai, bj, At, Bt) do { __builtin_amdgcn_s_setprio(1); _Pragma("unroll") for (int m = 0; m < 4; ++m) _Pragma("unroll") for (int n = 0; n < 2; ++n) _Pragma("unroll") for (int k = 0; k < 2; ++k) \
        acc[ai][bj][m][n] = __builtin_amdgcn_mfma_f32_16x16x32_bf16(Bt[n][k], At[m][k], acc[ai][bj][m][n], 0, 0, 0); __builtin_amdgcn_s_setprio(0); } while (0)
#define PG8_WAIT_V(n) asm volatile("s_waitcnt vmcnt(" #n ")" ::: "memory")
#define PG8_WAIT_L(n) asm volatile("s_waitcnt lgkmcnt(" #n ")" ::: "memory")
#define PG8_BAR __builtin_amdgcn_s_barrier()
#define PG8_SCHED __builtin_amdgcn_sched_barrier(0)
    Unit cur, nxt; int ui = 0;
    if (!S.next(0, cur)) return;
    f32x4 acc[2][2][4][2];
#pragma unroll
    for (int a = 0; a < 2; ++a)
#pragma unroll
        for (int b = 0; b < 2; ++b)
#pragma unroll
            for (int m = 0; m < 4; ++m)
#pragma unroll
                for (int n = 0; n < 2; ++n) acc[a][b][m][n] = (f32x4){0.f, 0.f, 0.f, 0.f};
    bf16x8 At[4][2], B0[2][2], B1[2][2];
#define PG8_KOFF(u) ((Sched::SPLITK && (u).kh > 0) ? (size_t)K : (size_t)0)
    const char* cA = (const char*)g.A + (size_t)cur.pm * tstep + PG8_KOFF(cur); const char* cB = (const char*)g.Bt + (size_t)cur.pn * tstep + PG8_KOFF(cur);
    PG8_STAGE(PG8_SB(0, 0), cB, voffB); PG8_STAGE(PG8_SA(0, 0), cA, voffA); PG8_STAGE(PG8_SB(0, 1), cB + hstep, voffB); PG8_STAGE(PG8_SA(0, 1), cA + hstep, voffA);
    if (wr == 1) PG8_BAR;
    PG8_WAIT_V(4); PG8_BAR;
    PG8_STAGE(PG8_SB(1, 0), cB + kstep, voffB); PG8_STAGE(PG8_SA(1, 0), cA + kstep, voffA); PG8_STAGE(PG8_SB(1, 1), cB + hstep + kstep, voffB);
    PG8_WAIT_V(6); PG8_BAR;
    for (;;) {
        const bool has_next = S.next(ui + 1, nxt);
        const char* nA = has_next ? (const char*)g.A + (size_t)nxt.pm * tstep + PG8_KOFF(nxt) : cA; const char* nB = has_next ? (const char*)g.Bt + (size_t)nxt.pn * tstep + PG8_KOFF(nxt) : cB;
        const int ntu = (Sched::SPLITK && cur.kh >= 0) ? nt / 2 : nt;
        for (int t = 0; t < ntu; t += 2) {
            const bool last = (t == ntu - 2);
            const char* a1 = cA + (size_t)(t + 1) * kstep;
            const char* a2 = last ? nA : cA + (size_t)(t + 2) * kstep; const char* b2 = last ? nB : cB + (size_t)(t + 2) * kstep;
            const char* a3 = a2 + kstep; const char* b3 = b2 + kstep;
            PG8_LDB(B0, 0, 0); PG8_SCHED; PG8_LDA(At, 0, 0); PG8_STAGE(PG8_SA(1, 1), a1 + hstep, voffA);
            PG8_WAIT_L(8); PG8_BAR; PG8_WAIT_L(0); PG8_MMA(0, 0, At, B0); PG8_BAR; PG8_SCHED;
            PG8_LDB(B1, 0, 1); PG8_STAGE(PG8_SB(0, 0), b2, voffB);
            PG8_BAR; PG8_WAIT_L(0); PG8_MMA(0, 1, At, B1); PG8_BAR;
            PG8_LDA(At, 0, 1); PG8_STAGE(PG8_SA(0, 0), a2, voffA);
            PG8_BAR; PG8_WAIT_L(0); PG8_MMA(1, 0, At, B0); PG8_BAR; PG8_SCHED;
            PG8_STAGE(PG8_SB(0, 1), b2 + hstep, voffB);
            PG8_WAIT_V(6); PG8_BAR; PG8_MMA(1, 1, At, B1); PG8_BAR;
            PG8_LDB(B0, 1, 0); PG8_SCHED; PG8_LDA(At, 1, 0); PG8_STAGE(PG8_SA(0, 1), a2 + hstep, voffA);
            PG8_WAIT_L(8); PG8_BAR; PG8_WAIT_L(0); PG8_MMA(0, 0, At, B0); PG8_BAR; PG8_SCHED;
            PG8_LDB(B1, 1, 1); PG8_STAGE(PG8_SB(1, 0), b3, voffB);
            PG8_BAR; PG8_WAIT_L(0); PG8_MMA(0, 1, At, B1); PG8_BAR;
            PG8_LDA(At, 1, 1); PG8_STAGE(PG8_SA(1, 0), a3, voffA);
            PG8_BAR; PG8_WAIT_L(0); PG8_MMA(1, 0, At, B0); PG8_BAR; PG8_SCHED;
            PG8_STAGE(PG8_SB(1, 1), b3 + hstep, voffB);
            PG8_WAIT_V(6); PG8_BAR; PG8_MMA(1, 1, At, B1); PG8_BAR;
        }
        E(acc, cur, wr, wc, fr, fq);
        if (!has_next) break;
#pragma unroll
        for (int a = 0; a < 2; ++a)
#pragma unroll
            for (int b = 0; b < 2; ++b)
#pragma unroll
                for (int m = 0; m < 4; ++m)
#pragma unroll
                    for (int n = 0; n < 2; ++n) acc[a][b][m][n] = (f32x4){0.f, 0.f, 0.f, 0.f};
        cur = nxt; cA = nA; cB = nB; ++ui;
    }
    PG8_WAIT_V(0);
    if (wr == 0) PG8_BAR;
    PG8_BAR;
#undef PG8_KOFF
#undef PG8_SA
#undef PG8_SB
#undef PG8_STAGE
#undef PG8_LDA
#undef PG8_LDB
#undef PG8_MMA
#undef PG8_WAIT_V
#undef PG8_WAIT_L
#undef PG8_BAR
#undef PG8_SCHED
}
template <class Epi, class Sched>
__device__ __forceinline__ void gemm_phase_gather(LAS unsigned char* lds, const int tid, const Gemm g, const Sched& S, const Epi& E, const LAS int* idxl) {
    const int wid = __builtin_amdgcn_readfirstlane(tid >> 6), lane = tid & 63, wr = wid >> 2, wc = wid & 3, fr = lane & 15, fq = lane >> 4;
    const int K = g.K, nt = K / BK;
    unsigned voffA[2], voffB[2];
#pragma unroll
    for (int i = 0; i < 2; ++i) { int R, C; stage_rc(tid * 16 + i * 8192, R, C); const int Rb = Epi::PERM ? ((R & ~31) + perm32(R & 31)) : R;
        voffA[i] = (unsigned)(R * K + C) * 2u; voffB[i] = (unsigned)(Rb * K + C) * 2u; }
    unsigned gcur[2][2];
#define PG8_GOFF(dst, unit) do { int _tz = tid; asm volatile("" : "+v"(_tz)); _Pragma("unroll") for (int _i = 0; _i < 2; ++_i) { int _R, _C; stage_rc(_tz * 16 + _i * 8192, _R, _C); \
        _Pragma("unroll") for (int _h = 0; _h < 2; ++_h) dst[_h][_i] = (unsigned)idxl[(unit) * 256 + _h * HALF + _R] * (unsigned)(K * 2) + (unsigned)_C * 2u; } } while (0)
    const size_t kstep = (size_t)(BK * 2);
    const size_t hstep = (size_t)HALF * K * 2;
    const size_t tstep = 2 * hstep;
    const unsigned ldsw = (unsigned)wid * 1024u;
    const int aoff = lds_byte(wr * 64 + fr, fq * 8), boff = lds_byte(wc * 32 + fr, fq * 8);
#define PG8_SA(b, h) (((b) * 2 + (h)) * HTB)
#define PG8_SB(b, h) ((4 + (b) * 2 + (h)) * HTB)
#define PG8_STAGE(bufoff, gbase, voff) do { _Pragma("unroll") for (int _i = 0; _i < 2; ++_i) \
        __builtin_amdgcn_global_load_lds((const unsigned*)((const char*)(gbase) + (voff)[_i]), (LAS unsigned*)(lds + (bufoff) + ldsw + _i * 8192), 16, 0, 0); } while (0)
#define PG8_LDA(dst, b, h) do { _Pragma("unroll") for (int m = 0; m < 4; ++m) _Pragma("unroll") for (int k = 0; k < 2; ++k) dst[m][k] = *(const LAS bf16x8*)(lds + PG8_SA(b, h) + aoff + m * 2048 + k * 1024); } while (0)
#define PG8_LDB(dst, b, h) do { _Pragma("unroll") for (int n = 0; n < 2; ++n) _Pragma("unroll") for (int k = 0; k < 2; ++k) dst[n][k] = *(const LAS bf16x8*)(lds + PG8_SB(b, h) + boff + n * 2048 + k * 1024); } while (0)
#define PG8_MMA(ai, bj, At, Bt) do { __builtin_amdgcn_s_setprio(1); _Pragma("unroll") for (int m = 0; m < 4; ++m) _Pragma("unroll") for (int n = 0; n < 2; ++n) _Pragma("unroll") for (int k = 0; k < 2; ++k) \
        acc[ai][bj][m][n] = __builtin_amdgcn_mfma_f32_16x16x32_bf16(Bt[n][k], At[m][k], acc[ai][bj][m][n], 0, 0, 0); __builtin_amdgcn_s_setprio(0); } while (0)
#define PG8_WAIT_V(n) asm volatile("s_waitcnt vmcnt(" #n ")" ::: "memory")
#define PG8_WAIT_L(n) asm volatile("s_waitcnt lgkmcnt(" #n ")" ::: "memory")
#define PG8_BAR __builtin_amdgcn_s_barrier()
#define PG8_SCHED __builtin_amdgcn_sched_barrier(0)
    Unit cur, nxt; int ui = 0;
    if (!S.next(0, cur)) return;
    f32x4 acc[2][2][4][2];
#pragma unroll
    for (int a = 0; a < 2; ++a)
#pragma unroll
        for (int b = 0; b < 2; ++b)
#pragma unroll
            for (int m = 0; m < 4; ++m)
#pragma unroll
                for (int n = 0; n < 2; ++n) acc[a][b][m][n] = (f32x4){0.f, 0.f, 0.f, 0.f};
    bf16x8 At[4][2], B0[2][2], B1[2][2];
    const char* const A0 = (const char*)g.A; const char* cB = (const char*)g.Bt + (size_t)cur.pn * tstep;
    PG8_GOFF(gcur, 0);
    PG8_STAGE(PG8_SB(0, 0), cB, voffB); PG8_STAGE(PG8_SA(0, 0), A0, gcur[0]); PG8_STAGE(PG8_SB(0, 1), cB + hstep, voffB); PG8_STAGE(PG8_SA(0, 1), A0, gcur[1]);
    if (wr == 1) PG8_BAR;
    PG8_WAIT_V(4); PG8_BAR;
    PG8_STAGE(PG8_SB(1, 0), cB + kstep, voffB); PG8_STAGE(PG8_SA(1, 0), A0 + kstep, gcur[0]); PG8_STAGE(PG8_SB(1, 1), cB + hstep + kstep, voffB);
    PG8_WAIT_V(6); PG8_BAR;
    for (;;) {
        const bool has_next = S.next(ui + 1, nxt);
        const char* nB = has_next ? (const char*)g.Bt + (size_t)nxt.pn * tstep : cB;
        for (int t = 0; t < nt; t += 2) {
            const bool last = (t == nt - 2);
            const char* a1 = A0 + (size_t)(t + 1) * kstep;
            const char* a2 = last ? A0 : A0 + (size_t)(t + 2) * kstep; const char* b2 = last ? nB : cB + (size_t)(t + 2) * kstep;
            unsigned sel[2][2];
            if (last && has_next) { PG8_GOFF(sel, ui + 1); } else { sel[0][0] = gcur[0][0]; sel[0][1] = gcur[0][1]; sel[1][0] = gcur[1][0]; sel[1][1] = gcur[1][1]; }
            const char* a3 = a2 + kstep; const char* b3 = b2 + kstep;
            PG8_LDB(B0, 0, 0); PG8_SCHED; PG8_LDA(At, 0, 0); PG8_STAGE(PG8_SA(1, 1), a1, gcur[1]);
            PG8_WAIT_L(8); PG8_BAR; PG8_WAIT_L(0); PG8_MMA(0, 0, At, B0); PG8_BAR; PG8_SCHED;
            PG8_LDB(B1, 0, 1); PG8_STAGE(PG8_SB(0, 0), b2, voffB);
            PG8_BAR; PG8_WAIT_L(0); PG8_MMA(0, 1, At, B1); PG8_BAR;
            PG8_LDA(At, 0, 1); PG8_STAGE(PG8_SA(0, 0), a2, sel[0]);
            PG8_BAR; PG8_WAIT_L(0); PG8_MMA(1, 0, At, B0); PG8_BAR; PG8_SCHED;
            PG8_STAGE(PG8_SB(0, 1), b2 + hstep, voffB);
            PG8_WAIT_V(6); PG8_BAR; PG8_MMA(1, 1, At, B1); PG8_BAR;
            PG8_LDB(B0, 1, 0); PG8_SCHED; PG8_LDA(At, 1, 0); PG8_STAGE(PG8_SA(0, 1), a2, sel[1]);
            PG8_WAIT_L(8); PG8_BAR; PG8_WAIT_L(0); PG8_MMA(0, 0, At, B0); PG8_BAR; PG8_SCHED;
            PG8_LDB(B1, 1, 1); PG8_STAGE(PG8_SB(1, 0), b3, voffB);
            PG8_BAR; PG8_WAIT_L(0); PG8_MMA(0, 1, At, B1); PG8_BAR;
            PG8_LDA(At, 1, 1); PG8_STAGE(PG8_SA(1, 0), a3, sel[0]);
            PG8_BAR; PG8_WAIT_L(0); PG8_MMA(1, 0, At, B0); PG8_BAR; PG8_SCHED;
            PG8_STAGE(PG8_SB(1, 1), b3 + hstep, voffB);
            PG8_WAIT_V(6); PG8_BAR; PG8_MMA(1, 1, At, B1); PG8_BAR;
        }
        E(acc, cur, wr, wc, fr, fq);
        if (!has_next) break;
#pragma unroll
        for (int a = 0; a < 2; ++a)
#pragma unroll
            for (int b = 0; b < 2; ++b)
#pragma unroll
                for (int m = 0; m < 4; ++m)
#pragma unroll
                    for (int n = 0; n < 2; ++n) acc[a][b][m][n] = (f32x4){0.f, 0.f, 0.f, 0.f};
        cur = nxt; cB = nB; ++ui;
        PG8_GOFF(gcur, ui);
    }
    PG8_WAIT_V(0);
    if (wr == 0) PG8_BAR;
    PG8_BAR;
#undef PG8_GOFF
#undef PG8_SA
#undef PG8_SB
#undef PG8_STAGE
#undef PG8_LDA
#undef PG8_LDB
#undef PG8_MMA
#undef PG8_WAIT_V
#undef PG8_WAIT_L
#undef PG8_BAR
#undef PG8_SCHED
}
}

struct Args { const float* in[29]; float* out; unsigned char* ws; int ph_lo, ph_hi; };
enum { I_X = 0, I_C, I_CTX, I_CCTX, I_WADA, I_BADA, I_N1G, I_N2G, I_WIN, I_WOUT, I_GWG, I_GBG, I_GNG, I_MNG, I_MWS, I_MBS, I_LCW, I_LCB, I_LWR, I_LBR, I_LWI, I_LBI, I_LLAM, I_RPB,
       I_WROUT, I_WGATE, I_WUP, I_WDOWN, I_FNG };

__device__ __forceinline__ const float* inp(const Args& A, int i) { asm volatile("" : "+s"(i)); return (const float*)(const GAS float*)A.in[i]; }
#define INP(i) inp(A, (i))

struct Frame {
    LAS unsigned char* lds;
    int tid, lane, wave, G, vcu, gw, NGW, bx;
    unsigned char* ws;
};
__device__ __forceinline__ Frame launder(const Frame& F0) {
    Frame F = F0;
    int tid = F0.tid, vcu = F0.vcu, G = F0.G, bx = F0.bx; GAS unsigned char* ws = (GAS unsigned char*)F0.ws;
    asm volatile("" : "+v"(tid)); asm volatile("" : "+s"(vcu)); asm volatile("" : "+s"(G)); asm volatile("" : "+s"(ws)); asm volatile("" : "+s"(bx));
    F.bx = bx; F.tid = tid; F.lane = tid & 63; F.wave = __builtin_amdgcn_readfirstlane(tid >> 6); F.vcu = vcu; F.G = G; F.ws = (unsigned char*)ws;
    F.gw = vcu * NWAVES + F.wave; F.NGW = G * NWAVES;
    return F;
}
__device__ __forceinline__ int row_set(int row) { return row < SEQ ? 0 : (row < 2 * SEQ ? 1 : (row < NLAT + CTX ? 2 : 3)); }
__device__ __forceinline__ int set_base(int set) { return set < 2 ? set * SEQ : NLAT + (set - 2) * CTX; }
__device__ __forceinline__ int chunk_row0(int b, int kk) { return kk < 4 ? NLAT + b * CTX + kk * 64 : b * SEQ + (kk - 4) * 64; }

__device__ __forceinline__ void cvt_block(const float* __restrict__ W, int N, int K, bf16_t* __restrict__ WT, size_t drow0, int k0, int n0, LAS float* scr, int lane) {
#pragma unroll
    for (int i = 0; i < 8; ++i) { const int kk = 8 * i + (lane >> 3), nn = (lane & 7) * 4;
        const f32x4 v = __builtin_nontemporal_load((const f32x4*)(W + (size_t)(k0 + kk) * N + n0 + nn));
        LAS float* s = scr + kk * 33 + nn; s[0] = v[0]; s[1] = v[1]; s[2] = v[2]; s[3] = v[3]; }
    LDS_WAIT();
    const int c = lane & 7;
#pragma unroll
    for (int j = 0; j < 4; ++j) { const int n = (lane >> 3) + 8 * j; const LAS float* s = scr + (8 * c) * 33 + n;
        u32x4 o; o.x = pk2(s[0 * 33], s[1 * 33]); o.y = pk2(s[2 * 33], s[3 * 33]); o.z = pk2(s[4 * 33], s[5 * 33]); o.w = pk2(s[6 * 33], s[7 * 33]);
        *(u32x4*)(WT + (drow0 + n) * (size_t)K + k0 + 8 * c) = o; }
    LDS_WAIT();
}
constexpr int CV_IN = 16 * 89, CV_OUT = 16 * 32, CV_G = 16 * 1024, CV_PER_L = CV_IN + CV_OUT + 3 * CV_G;
__device__ __forceinline__ void cvt_item(const Frame& F, const Args& A, int l, int r, LAS float* scr) {
    bf16_t* win_t = (bf16_t*)(F.ws + WS_WIN); bf16_t* wout_t = (bf16_t*)(F.ws + WS_WOUT); bf16_t* w1_t = (bf16_t*)(F.ws + WS_W1); bf16_t* w2_t = (bf16_t*)(F.ws + WS_W2);
    if (r < CV_IN) { const int kb = r / 89, nb = r % 89, n0 = nb * 32; const size_t dr = n0 < 1024 ? n0 : (n0 < 1056 ? 2816 : n0 - 32);
        cvt_block(INP(I_WIN) + (size_t)l * D * INC, INC, D, win_t + (size_t)l * INC * D, dr, kb * 64, n0, scr, F.lane); return; }
    r -= CV_IN;
    if (r < CV_OUT) { const int kb = r / 32, nb = r % 32; cvt_block(INP(I_WOUT) + (size_t)l * D * D, D, D, wout_t + (size_t)l * D * D, nb * 32, kb * 64, nb * 32, scr, F.lane); return; }
    r -= CV_OUT;
    if (r < 2 * CV_G) { const int up = r >= CV_G; if (up) r -= CV_G; const int e = r / 1024, q = r % 1024, kb = q / 64, nb = q % 64, n0 = nb * 32;
        const size_t dr = (size_t)e * 4096 + 256 * (n0 >> 7) + (n0 & 127) + (up ? 128 : 0);
        cvt_block((up ? INP(I_WUP) : INP(I_WGATE)) + (size_t)(l * NE + e) * D * FF, FF, D, w1_t + (size_t)l * NE * 4096 * D, dr, kb * 64, n0, scr, F.lane); return; }
    r -= 2 * CV_G;
    { const int e = r / 1024, q = r % 1024, kb = q / 32, nb = q % 32, n0 = nb * 32;
        cvt_block(INP(I_WDOWN) + (size_t)(l * NE + e) * FF * D, D, FF, w2_t + (size_t)l * NE * D * FF, (size_t)e * 1024 + n0, kb * 64, n0, scr, F.lane); }
}
struct CvtDesc { const float* W; bf16_t* WT; size_t dr; int N, K, k0, n0; };
__device__ __forceinline__ CvtDesc cvt_decode_moe(const Frame& F, const Args& A, int l, int r) {
    CvtDesc c; r -= CV_IN + CV_OUT;
    if (r < 2 * CV_G) { const int up = r >= CV_G; if (up) r -= CV_G; const int e = r / 1024, q = r % 1024, kb = q / 64, nb = q % 64, n0 = nb * 32;
        c.W = (up ? INP(I_WUP) : INP(I_WGATE)) + (size_t)(l * NE + e) * D * FF; c.WT = (bf16_t*)(F.ws + WS_W1) + (size_t)l * NE * 4096 * D; c.dr = (size_t)e * 4096 + 256 * (n0 >> 7) + (n0 & 127) + (up ? 128 : 0);
        c.N = FF; c.K = D; c.k0 = kb * 64; c.n0 = n0; return c; }
    r -= 2 * CV_G;
    { const int e = r / 1024, q = r % 1024, kb = q / 32, nb = q % 32, n0 = nb * 32;
        c.W = INP(I_WDOWN) + (size_t)(l * NE + e) * FF * D; c.WT = (bf16_t*)(F.ws + WS_W2) + (size_t)l * NE * D * FF; c.dr = (size_t)e * 1024 + n0; c.N = D; c.K = FF; c.k0 = kb * 64; c.n0 = n0; return c; }
}
constexpr int CQ4 = 40, CQ8 = 88, CQ8B = 32, CQ3 = 24, CQ6 = 0;
constexpr int CB4 = 0, CB8 = CB4 + 248 * CQ4, CB3 = CB8 + 128 * CQ8 + 128 * CQ8B, CB6 = CB3 + 126 * CQ3, CB_P5 = CB6 + 96 * CQ6, CQ5 = 8, CB_DRAIN = CB_P5 + CQ5 * 2048;
static_assert(CB_DRAIN <= CV_PER_L && CB8 >= CV_IN + CV_OUT, "conversion quotas");
__device__ __forceinline__ void cvt_issue(const CvtDesc& c, int lane, f32x4 (&v)[8]) {
#pragma unroll
    for (int i = 0; i < 8; ++i) { const int kk = 8 * i + (lane >> 3), nn = (lane & 7) * 4; v[i] = __builtin_nontemporal_load((const f32x4*)(c.W + (size_t)(c.k0 + kk) * c.N + c.n0 + nn)); }
}
__device__ __forceinline__ void cvt_finish(const CvtDesc& c, int lane, const f32x4 (&v)[8], LAS float* scr) {
#pragma unroll
    for (int i = 0; i < 8; ++i) { const int kk = 8 * i + (lane >> 3), nn = (lane & 7) * 4; LAS float* sp = scr + kk * 33 + nn; sp[0] = v[i][0]; sp[1] = v[i][1]; sp[2] = v[i][2]; sp[3] = v[i][3]; }
    LDS_WAIT();
    const int cc = lane & 7;
#pragma unroll
    for (int j = 0; j < 4; ++j) { const int n = (lane >> 3) + 8 * j; const LAS float* sp = scr + (8 * cc) * 33 + n;
        u32x4 o; o.x = pk2(sp[0 * 33], sp[1 * 33]); o.y = pk2(sp[2 * 33], sp[3 * 33]); o.z = pk2(sp[4 * 33], sp[5 * 33]); o.w = pk2(sp[6 * 33], sp[7 * 33]);
        *(u32x4*)(c.WT + (c.dr + n) * (size_t)c.K + c.k0 + 8 * cc) = o; }
    LDS_WAIT();
}
template <int NB>
__device__ __forceinline__ void cvt_group_moe(const Frame& F, const Args& A, int l, int r, int stride, LAS float* scr) {
    CvtDesc c[NB]; f32x4 v[NB][8];
#pragma unroll
    for (int b = 0; b < NB; ++b) { c[b] = cvt_decode_moe(F, A, l, r + b * stride); cvt_issue(c[b], F.lane, v[b]); }
    asm volatile("" ::: "memory");
#pragma unroll
    for (int b = 0; b < NB; ++b) cvt_finish(c[b], F.lane, v[b], scr);
}
__device__ __forceinline__ void cvt_range_moe4(const Frame& F, const Args& A, int l, int first, int count) {
    LAS float* scr = (LAS float*)(F.lds) + F.wave * (64 * 33);
    const int end = first + count; int r = first + F.wave;
    for (; r + 3 * NWAVES < end; r += 4 * NWAVES) cvt_group_moe<4>(F, A, l, r, NWAVES, scr);
    if (r + NWAVES < end) { cvt_group_moe<2>(F, A, l, r, NWAVES, scr); r += 2 * NWAVES; }
    if (r < end) cvt_group_moe<1>(F, A, l, r, NWAVES, scr);
}
__device__ __forceinline__ void cvt_range(const Frame& F, const Args& A, int l, int first, int count) {
    LAS float* scr = (LAS float*)(F.lds) + F.wave * (64 * 33);
    for (int r = first + F.wave; r < first + count; r += NWAVES) cvt_item(F, A, l, r, scr);
}
constexpr int ADA_ITEMS = DEPTH * 8 * 96;
constexpr int LRUW_ITEMS = DEPTH * 16;
__device__ __forceinline__ void p0_prologue(Frame& F, const Args& A) {
    LAS float* scr = (LAS float*)(F.lds) + F.wave * (64 * 33);
    LAS float* sil = (LAS float*)(F.lds + 8 * 64 * 33 * 4);
    for (int i = F.tid; i < 3 * D; i += 512) { const float v = i < 2 * D ? INP(I_C)[i] : INP(I_CCTX)[i - 2 * D]; sil[i] = siluf_(v); }
    __syncthreads();
    float* modp = (float*)(F.ws + WS_MODP);
    bf16_t* win_t = (bf16_t*)(F.ws + WS_WIN); bf16_t* wout_t = (bf16_t*)(F.ws + WS_WOUT); bf16_t* w1_t = (bf16_t*)(F.ws + WS_W1); bf16_t* w2_t = (bf16_t*)(F.ws + WS_W2);
    for (int idx = F.gw * 64 + F.lane; idx < 128 * 16; idx += F.NGW * 64) { const float ang = (float)(idx >> 4) * rope_inv(idx & 15); float sn, cs; sincosf(ang, &sn, &cs);
        ((f32x2*)(F.ws + WS_ROPE))[idx] = (f32x2){cs, sn}; }
    const int total = ADA_ITEMS + CV_PER_L + LRUW_ITEMS;
    for (int it = F.gw; it < total; it += F.NGW) {
        if (it >= ADA_ITEMS + CV_PER_L) {
            const int m = it - (ADA_ITEMS + CV_PER_L), l = m >> 4, q = m & 15, d = q >> 3, gate = (q >> 2) & 1, g = q & 3;
            const float* W = (gate ? INP(I_LWI) : INP(I_LWR)) + ((size_t)((l * 2 + d) * 4 + g) * 64) * 64 + F.lane;
            bf16_t* WT = (bf16_t*)(F.ws + WS_LRUW) + ((size_t)(((l * 2 + d) * 2 + gate) * 4 + g) * 64 + F.lane) * 64;
#pragma unroll
            for (int c = 0; c < 8; ++c) { float v[8];
#pragma unroll
                for (int u = 0; u < 8; ++u) v[u] = W[(size_t)(8 * c + u) * 64];
                u32x4 o; o.x = pk2(v[0], v[1]); o.y = pk2(v[2], v[3]); o.z = pk2(v[4], v[5]); o.w = pk2(v[6], v[7]);
                *(u32x4*)(WT + 8 * c) = o; }
            continue;
        }
        if (it < ADA_ITEMS) {
            const int l = it / 768, r = it % 768, p = r / 96, cb = r % 96, j = cb * 64 + F.lane, k0 = p * 128;
            const float* w = INP(I_WADA) + ((size_t)l * D + k0) * 6144 + j;
            float s0 = 0.f, s1 = 0.f, s2 = 0.f;
#pragma unroll 32
            for (int k = 0; k < 128; ++k) { const float wv = w[(size_t)k * 6144]; s0 += sil[k0 + k] * wv; s1 += sil[D + k0 + k] * wv; s2 += sil[2 * D + k0 + k] * wv; }
            float* o = modp + ((size_t)(l * 8 + p) * 3) * 6144 + j;
            o[0] = s0; o[6144] = s1; o[2 * 6144] = s2;
            continue;
        }
        cvt_item(F, A, 0, it - ADA_ITEMS, scr);
    }
}

__device__ __forceinline__ float mod_val(const Frame& F, const Args& A, int l, int s, int j) {
    const float* modp = (const float*)(F.ws + WS_MODP) + ((size_t)(l * 8) * 3 + s) * 6144 + j;
    float v = INP(I_BADA)[l * 6144 + j];
#pragma unroll
    for (int p = 0; p < 8; ++p) v += modp[(size_t)p * 3 * 6144];
    return v;
}

__device__ __forceinline__ void p1_norm1(Frame& F, const Args& A, int l, bool dry = false) {
    if (l >= 1 && l < DEPTH && !dry) {
        LAS float* scr = (LAS float*)(F.lds + 65536) + F.wave * (64 * 33);
        for (int r = (F.G == 256 ? CB_DRAIN : 0) + F.gw; r < CV_PER_L; r += F.NGW) cvt_item(F, A, l, r, scr);
    }
    LAS float* sc = (LAS float*)F.lds;
    LAS float* sh = sc + 3 * D;
    LAS float* g2 = sh + 3 * D;
    LAS float* ng = g2 + 3 * D;
    const float* mod = (const float*)(F.ws + WS_MOD); float* modw = dry ? (float*)(F.ws + WS_HID + (size_t)120 * MiB) : (float*)(F.ws + WS_MOD);
    if (l == 0) { for (int i = F.tid; i < 3 * D; i += 512) { const int s = i >> 10, j = i & 1023; sh[i] = mod_val(F, A, l, s, j); sc[i] = 1.0f + mod_val(F, A, l, s, 1024 + j); } }
    else {
        f32x4 m[6];
#pragma unroll
        for (int u = 0; u < 2; ++u) { const int i4 = F.tid + 512 * u, i = 4 * i4, s = i >> 10, j = i & 1023; m[3 * u] = (f32x4){0.f, 0.f, 0.f, 0.f}; m[3 * u + 1] = m[3 * u]; m[3 * u + 2] = m[3 * u];
            if (i4 < 768) { if (l < DEPTH) { m[3 * u] = *(const f32x4*)(mod + ((size_t)l * 3 + s) * 6144 + j); m[3 * u + 1] = *(const f32x4*)(mod + ((size_t)l * 3 + s) * 6144 + 1024 + j); }
                m[3 * u + 2] = *(const f32x4*)(mod + ((size_t)(l - 1) * 3 + s) * 6144 + 5120 + j); } }
        pin6(m);
#pragma unroll
        for (int u = 0; u < 2; ++u) { const int i4 = F.tid + 512 * u, i = 4 * i4;
            if (i4 < 768) { if (l < DEPTH) { *(LAS f32x4*)(sh + i) = m[3 * u]; *(LAS f32x4*)(sc + i) = m[3 * u + 1] + 1.0f; } *(LAS f32x4*)(g2 + i) = m[3 * u + 2]; } } }
    if (F.tid < 256) *(LAS f32x4*)(ng + 4 * F.tid) = *(const f32x4*)((l < DEPTH ? INP(I_N1G) + l * D : INP(I_FNG)) + 4 * F.tid);
    if (l == 0) for (int i = F.bx * 512 + F.tid; i < DEPTH * 3 * 6144; i += F.G * 512) { const int ll = i / (3 * 6144), r = i % (3 * 6144); modw[i] = mod_val(F, A, ll, r / 6144, r % 6144); }
    __syncthreads();
    const bf16_t* X = (const bf16_t*)(F.ws + WS_X); bf16_t* Xw = dry ? (bf16_t*)(F.ws + WS_HID) : (bf16_t*)(F.ws + WS_X); bf16_t* H = dry ? (bf16_t*)(F.ws + WS_HID + (size_t)80 * MiB) : (bf16_t*)(F.ws + WS_H);
    float* outp = dry ? (float*)(F.ws + WS_HID) : A.out;
    const int* SLOT = (const int*)(F.ws + WS_SLOT); const float* GSEL = (const float*)(F.ws + WS_GSEL); const bf16_t* Y = (const bf16_t*)(F.ws + WS_Y); const bf16_t* Y2 = (const bf16_t*)(F.ws + WS_Y2);
    const int nrows = l < DEPTH ? MROWS : NLAT;
    const float* xin = INP(I_X); const float* cin = INP(I_CTX);
    u32x4 vr[4]; int slot = -1;
#pragma unroll
    for (int j = 0; j < 4; ++j) vr[j] = (u32x4){0u, 0u, 0u, 0u};
    { const int row = F.gw;
        if (row < nrows) { const int set = row_set(row), tok = row - set_base(set);
            if (l == 0) { const float* src = set < 2 ? xin + (size_t)row * D : cin + (size_t)(row - NLAT) * D;
#pragma unroll
                for (int j = 0; j < 4; ++j) vr[j] = *(const u32x4*)(src + 4 * F.lane + 256 * j); }
            else {
#pragma unroll
                for (int j = 0; j < 4; ++j) { const u32x2 t = *(const u32x2*)(X + (size_t)row * D + 4 * F.lane + 256 * j); vr[j].x = t.x; vr[j].y = t.y; } }
            if (l > 0 && F.lane < NE) slot = set < 2 ? SLOT[((size_t)set * NE + F.lane) * SEQ + tok] : SLOT[(size_t)2 * NE * SEQ + ((size_t)(set - 2) * NE + F.lane) * CTX + tok]; } }
    for (int row = F.gw; row < nrows; row += F.NGW) {
        const int set = row_set(row), ms = set < 2 ? set : 2;
        u32x4 nv[4]; int nslot = -1;
#pragma unroll
        for (int j = 0; j < 4; ++j) nv[j] = (u32x4){0u, 0u, 0u, 0u};
        { const int nrow = row + F.NGW;
            if (nrow < nrows) { const int nset = row_set(nrow), ntok = nrow - set_base(nset);
                if (l == 0) { const float* src = nset < 2 ? xin + (size_t)nrow * D : cin + (size_t)(nrow - NLAT) * D;
#pragma unroll
                    for (int j = 0; j < 4; ++j) nv[j] = *(const u32x4*)(src + 4 * F.lane + 256 * j); }
                else {
#pragma unroll
                    for (int j = 0; j < 4; ++j) { const u32x2 t = *(const u32x2*)(X + (size_t)nrow * D + 4 * F.lane + 256 * j); nv[j].x = t.x; nv[j].y = t.y; } }
                if (l > 0 && F.lane < NE) nslot = nset < 2 ? SLOT[((size_t)nset * NE + F.lane) * SEQ + ntok] : SLOT[(size_t)2 * NE * SEQ + ((size_t)(nset - 2) * NE + F.lane) * CTX + ntok]; } }
        f32x4 v[4];
#pragma unroll
        for (int j = 0; j < 4; ++j) v[j] = l == 0 ? (f32x4){__uint_as_float(vr[j].x), __uint_as_float(vr[j].y), __uint_as_float(vr[j].z), __uint_as_float(vr[j].w)}
                                                  : (f32x4){__uint_as_float(vr[j].x << 16), __uint_as_float(vr[j].x & 0xffff0000u), __uint_as_float(vr[j].y << 16), __uint_as_float(vr[j].y & 0xffff0000u)};
        if (l > 0) {
            unsigned long long m = __ballot(slot >= 0);
            f32x4 acc[4];
#pragma unroll
            for (int j = 0; j < 4; ++j) acc[j] = (f32x4){0.f, 0.f, 0.f, 0.f};
            const int xbase = set < 2 ? set * 1024 : 2048 + (set - 2) * 32;
            while (m) {
                const int e0 = __builtin_ctzll(m); m &= m - 1; const bool two = m != 0ull; const int e1 = two ? __builtin_ctzll(m) : e0; if (two) m &= m - 1;
                const int x0 = e0 * XS_PER_E + xbase + __shfl(slot, e0), x1 = e1 * XS_PER_E + xbase + __shfl(slot, e1);
                const float g0 = GSEL[x0], g1 = two ? GSEL[x1] : 0.f;
                const bf16_t* y0 = Y + (size_t)x0 * D + 4 * F.lane; const bf16_t* y1 = Y + (size_t)x1 * D + 4 * F.lane;
                u32x2 w0[4], w1[4];
#pragma unroll
                for (int j = 0; j < 4; ++j) { w0[j] = *(const u32x2*)(y0 + 256 * j); w1[j] = *(const u32x2*)(y1 + 256 * j); }
                if (set >= 2) {
                    const bf16_t* z0 = Y2 + (size_t)(e0 * 256 + (x0 - e0 * XS_PER_E - 2048)) * D + 4 * F.lane; const bf16_t* z1 = Y2 + (size_t)(e1 * 256 + (x1 - e1 * XS_PER_E - 2048)) * D + 4 * F.lane;
                    u32x2 u0[4], u1[4];
#pragma unroll
                    for (int j = 0; j < 4; ++j) { u0[j] = *(const u32x2*)(z0 + 256 * j); u1[j] = *(const u32x2*)(z1 + 256 * j); }
#pragma unroll
                    for (int j = 0; j < 4; ++j) { acc[j][0] += g0 * bf2f(u0[j].x & 0xffffu); acc[j][1] += g0 * bf2f(u0[j].x >> 16); acc[j][2] += g0 * bf2f(u0[j].y & 0xffffu); acc[j][3] += g0 * bf2f(u0[j].y >> 16);
                        acc[j][0] += g1 * bf2f(u1[j].x & 0xffffu); acc[j][1] += g1 * bf2f(u1[j].x >> 16); acc[j][2] += g1 * bf2f(u1[j].y & 0xffffu); acc[j][3] += g1 * bf2f(u1[j].y >> 16); } }
#pragma unroll
                for (int j = 0; j < 4; ++j) { acc[j][0] += g0 * bf2f(w0[j].x & 0xffffu); acc[j][1] += g0 * bf2f(w0[j].x >> 16); acc[j][2] += g0 * bf2f(w0[j].y & 0xffffu); acc[j][3] += g0 * bf2f(w0[j].y >> 16); }
#pragma unroll
                for (int j = 0; j < 4; ++j) { acc[j][0] += g1 * bf2f(w1[j].x & 0xffffu); acc[j][1] += g1 * bf2f(w1[j].x >> 16); acc[j][2] += g1 * bf2f(w1[j].y & 0xffffu); acc[j][3] += g1 * bf2f(w1[j].y >> 16); }
            }
#pragma unroll
            for (int j = 0; j < 4; ++j) { const f32x4 gg = *(const LAS f32x4*)(g2 + ms * D + 4 * F.lane + 256 * j); v[j] = v[j] + gg * acc[j]; }
        }
        if (l < DEPTH) {
#pragma unroll
            for (int j = 0; j < 4; ++j) { u32x2 w; w.x = pg8::cvt_pk_bf16(v[j][0], v[j][1]); w.y = pg8::cvt_pk_bf16(v[j][2], v[j][3]); *(u32x2*)(Xw + (size_t)row * D + 4 * F.lane + 256 * j) = w; }
        }
        float ss = 0.f;
#pragma unroll
        for (int j = 0; j < 4; ++j) ss += (v[j][0] * v[j][0] + v[j][1] * v[j][1]) + (v[j][2] * v[j][2] + v[j][3] * v[j][3]);
        const float rstd = 1.0f / sqrtf(wave_sum(ss) * (1.0f / D) + EPS);
        if (l < DEPTH) {
#pragma unroll
            for (int j = 0; j < 4; ++j) { const int c0 = 4 * F.lane + 256 * j;
                const f32x4 gn = *(const LAS f32x4*)(ng + c0), s1 = *(const LAS f32x4*)(sc + ms * D + c0), h1 = *(const LAS f32x4*)(sh + ms * D + c0);
                const f32x4 o = v[j] * rstd * gn * s1 + h1;
                u32x2 w; w.x = pg8::cvt_pk_bf16(o[0], o[1]); w.y = pg8::cvt_pk_bf16(o[2], o[3]);
                *(u32x2*)(H + (size_t)row * D + c0) = w; }
        } else {
#pragma unroll
            for (int j = 0; j < 4; ++j) { const int c0 = 4 * F.lane + 256 * j; const f32x4 gn = *(const LAS f32x4*)(ng + c0);
                *(f32x4*)(outp + (size_t)row * D + c0) = v[j] * rstd * gn; }
        }
#pragma unroll
        for (int j = 0; j < 4; ++j) vr[j] = nv[j];
        slot = nslot;
    }
}

__device__ __forceinline__ void p2_gate_feats(Frame& F, int l) {
    const bf16_t* H = (const bf16_t*)(F.ws + WS_H);
    const bf16_t* WG = (const bf16_t*)(F.ws + WS_WIN) + ((size_t)l * INC + PC) * D;
    float* Z = (float*)(F.ws + WS_Z);
    const int rem = (MROWS / 256 * (PC / 256)) % F.G, nidle = F.G - rem;
    if (F.bx < rem) return;
    constexpr int WP2 = 1032;
    LAS bf16_t* wl = (LAS bf16_t*)F.lds;
    { u32x4 wv[8];
#pragma unroll
        for (int u = 0; u < 8; ++u) { const int idx = F.tid + 512 * u, r = idx >> 7, c8 = (idx & 127) * 8; wv[u] = *(const u32x4*)(WG + (size_t)r * D + c8); }
#pragma unroll
        for (int u = 0; u < 8; ++u) { const int idx = F.tid + 512 * u, r = idx >> 7, c8 = (idx & 127) * 8; *(LAS u32x4*)(wl + r * WP2 + c8) = wv[u]; } }
    __syncthreads();
    const int fr = F.lane & 15, fq = F.lane >> 4;
    for (int tb = (F.bx - rem) * NWAVES + F.wave; tb < MROWS / 16; tb += nidle * NWAVES) {
        const int r0 = tb * 16;
        f32x4 a0 = (f32x4){0.f, 0.f, 0.f, 0.f}, a1 = a0;
        const bf16_t* ap = H + (size_t)(r0 + fr) * D + fq * 8;
        const LAS bf16_t* bp0 = wl + fr * WP2 + fq * 8; const LAS bf16_t* bp1 = wl + (16 + fr) * WP2 + fq * 8;
#pragma unroll 1
        for (int kb = 0; kb < 2; ++kb) {
            bf16x8 av[16];
#pragma unroll
            for (int u = 0; u < 16; ++u) av[u] = *(const bf16x8*)(ap + (kb * 16 + u) * 32);
            asm volatile("" : "+v"(av[0]), "+v"(av[1]), "+v"(av[2]), "+v"(av[3]), "+v"(av[4]), "+v"(av[5]), "+v"(av[6]), "+v"(av[7]),
                              "+v"(av[8]), "+v"(av[9]), "+v"(av[10]), "+v"(av[11]), "+v"(av[12]), "+v"(av[13]), "+v"(av[14]), "+v"(av[15]) :: "memory");
#pragma unroll
            for (int u = 0; u < 16; ++u) { a0 = __builtin_amdgcn_mfma_f32_16x16x32_bf16(av[u], *(const LAS bf16x8*)(bp0 + (kb * 16 + u) * 32), a0, 0, 0, 0);
                a1 = __builtin_amdgcn_mfma_f32_16x16x32_bf16(av[u], *(const LAS bf16x8*)(bp1 + (kb * 16 + u) * 32), a1, 0, 0, 0); }
        }
#pragma unroll
        for (int j = 0; j < 4; ++j) { Z[(size_t)(r0 + 4 * fq + j) * 32 + fr] = a0[j]; Z[(size_t)(r0 + 4 * fq + j) * 32 + 16 + fr] = a1[j]; }
    }
}


__device__ __forceinline__ void gla_load_gates_t(const Frame& F, const Args& A, int l, int h, int row0, LAS float* zs, LAS float* wg, LAS float* bg) {
    const float* Z = (const float*)(F.ws + WS_Z);
    for (int idx = F.tid; idx < 64 * 32; idx += 512) zs[idx] = Z[(size_t)row0 * 32 + idx];
    for (int idx = F.tid; idx < 2 * 16 * 64; idx += 512) { const int d = idx >> 10, r = (idx >> 6) & 15, dk = idx & 63; wg[(d * 64 + dk) * 16 + r] = INP(I_GWG)[((size_t)(l * 2 + d) * 16 + r) * 256 + h * 64 + dk]; }
    if (F.tid < 128) { const int d = F.tid >> 6, dk = F.tid & 63; bg[F.tid] = INP(I_GBG)[(size_t)(l * 2 + d) * 256 + h * 64 + dk]; }
}
__device__ __forceinline__ void t_gla_scan(Frame& F, int task, bool dry = false) {
    const int e = task * 512 + F.tid; const int dvk = e & 4095, chain = e >> 12;
    const int d = chain >> 3, dk = dvk & 63;
    const bf16_t* KV = (const bf16_t*)(F.ws + WS_KV) + (size_t)chain * NCH * 4096 + dvk; bf16_t* SS = (bf16_t*)(F.ws + WS_SS) + (size_t)chain * NCH * 4096 + dvk;
    const float* DEC = (const float*)(F.ws + WS_DEC) + (size_t)chain * NCH * 64 + dk;
    (void)dry;
    float S = 0.f;
    for (int n0 = 0; n0 < NCH; n0 += 22) {
        float dc[22]; unsigned kv[22]; int idx[22];
#pragma unroll
        for (int u = 0; u < 22; ++u) { const int n = n0 + u; idx[u] = d == 0 ? n : (n < 4 ? 3 - n : NCH - 1 - (n - 4)); kv[u] = KV[(size_t)idx[u] * 4096]; dc[u] = DEC[idx[u] * 64]; }
#pragma unroll
        for (int u = 0; u < 22; ++u) { SS[(size_t)idx[u] * 4096] = (bf16_t)f2bf(S); S = S * dc[u] + bf2f(kv[u]); }
    }
}
constexpr int GP = 72;
__device__ __forceinline__ float wave_incl_scan(float v) {
    v += __int_as_float(__builtin_amdgcn_update_dpp(0, __float_as_int(v), 0x111, 0xf, 0xf, true));
    v += __int_as_float(__builtin_amdgcn_update_dpp(0, __float_as_int(v), 0x112, 0xf, 0xf, true));
    v += __int_as_float(__builtin_amdgcn_update_dpp(0, __float_as_int(v), 0x114, 0xf, 0xf, true));
    v += __int_as_float(__builtin_amdgcn_update_dpp(0, __float_as_int(v), 0x118, 0xf, 0xf, true));
    v += __int_as_float(__builtin_amdgcn_update_dpp(0, __float_as_int(v), 0x142, 0xa, 0xf, false));
    v += __int_as_float(__builtin_amdgcn_update_dpp(0, __float_as_int(v), 0x143, 0xc, 0xf, false));
    return v;
}
__device__ __forceinline__ void t_gla_main(Frame& F, const Args& A, int l, int task, bool need_ctx) {
    const int h = task & 3, kk = (task >> 2) % NCH, b = task / (4 * NCH);
    const int row0 = chunk_row0(b, kk);
    const bool want_o = kk >= 4 || need_ctx;
    const bf16_t* P = (const bf16_t*)(F.ws + WS_P);
    LAS float* Bc = (LAS float*)F.lds; LAS float* zs = Bc + 2 * 64 * 65; LAS float* wg = zs + 64 * 32; LAS float* bg = wg + 2 * 16 * 64;
    LAS bf16_t* QI = (LAS bf16_t*)(bg + 128);
    LAS bf16_t* KI = QI + 2 * 64 * GP;
    LAS bf16_t* KE = KI + 2 * 64 * GP;
    LAS bf16_t* VT = KE + 2 * 64 * GP;
    LAS float* OM = (LAS float*)(VT + 64 * GP);
    const int i = F.tid >> 3, sub = F.tid & 7, pc = sub >> 1, hf = sub & 1, c1 = pc < 2 ? pc : pc + 2, d0 = 8 * c1 + 4 * hf;
    const bf16_t* pr = P + (size_t)(row0 + i) * PC + h * 64 + d0;
    const u32x2 kA = *(const u32x2*)(pr + C_K), kB = *(const u32x2*)(pr + C_K + 16), vA = *(const u32x2*)(pr + C_V), vB = *(const u32x2*)(pr + C_V + 16);
    const u32x2 qA = *(const u32x2*)(pr + C_Q), qB = *(const u32x2*)(pr + C_Q + 16);
    f32x4 gl[4]; float bgv = 0.f;
    const int gd = F.tid >> 8, gr = (F.tid >> 4) & 15, gdk4 = (F.tid & 15) * 4;
    gl[0] = *(const f32x4*)((const float*)(F.ws + WS_Z) + (size_t)row0 * 32 + 4 * F.tid);
    gl[1] = *(const f32x4*)(INP(I_GWG) + ((size_t)(l * 2 + gd) * 16 + gr) * 256 + h * 64 + gdk4);
    gl[2] = (f32x4){0.f, 0.f, 0.f, 0.f}; gl[3] = gl[2];
    if (kk >= 4) { const int pos = pc < 2 ? kk - 4 : i; const int a = d0 & 15;
        const f32x4* rt = (const f32x4*)((const float*)(F.ws + WS_ROPE) + ((size_t)pos * 16 + a) * 2); gl[2] = rt[0]; gl[3] = rt[1]; }
    if (F.tid < 128) bgv = INP(I_GBG)[(size_t)(l * 2 + (F.tid >> 6)) * 256 + h * 64 + (F.tid & 63)];
    pin4(gl); pin1(bgv);
    *(LAS f32x4*)(zs + 4 * F.tid) = gl[0];
#pragma unroll
    for (int k = 0; k < 4; ++k) wg[(gd * 64 + gdk4 + k) * 16 + gr] = gl[1][k];
    if (F.tid < 128) bg[F.tid] = bgv;
    float k1[4] = {bf2f(kA.x & 0xffffu), bf2f(kA.x >> 16), bf2f(kA.y & 0xffffu), bf2f(kA.y >> 16)}, k2[4] = {bf2f(kB.x & 0xffffu), bf2f(kB.x >> 16), bf2f(kB.y & 0xffffu), bf2f(kB.y >> 16)};
    float q1[4] = {bf2f(qA.x & 0xffffu), bf2f(qA.x >> 16), bf2f(qA.y & 0xffffu), bf2f(qA.y >> 16)}, q2[4] = {bf2f(qB.x & 0xffffu), bf2f(qB.x >> 16), bf2f(qB.y & 0xffffu), bf2f(qB.y >> 16)};
    if (kk >= 4) {
        const f32x4 r0 = gl[2], r1 = gl[3]; const float cs[4] = {r0[0], r0[2], r1[0], r1[2]}, sn[4] = {r0[1], r0[3], r1[1], r1[3]};
#pragma unroll
        for (int e = 0; e < 4; ++e) { const float ka = k1[e] * cs[e] - k2[e] * sn[e], kb = k1[e] * sn[e] + k2[e] * cs[e]; k1[e] = ka; k2[e] = kb;
            const float qa = q1[e] * cs[e] - q2[e] * sn[e], qb = q1[e] * sn[e] + q2[e] * cs[e]; q1[e] = qa; q2[e] = qb; } }
    __syncthreads();
    { const int d = F.wave >> 2, dk0 = 16 * (F.wave & 3), ti = d == 0 ? F.lane : 63 - F.lane;
        float z[16];
#pragma unroll
        for (int r = 0; r < 16; r += 4) { const f32x4 t4 = *(const LAS f32x4*)(zs + ti * 32 + d * 16 + r); z[r] = t4[0]; z[r + 1] = t4[1]; z[r + 2] = t4[2]; z[r + 3] = t4[3]; }
#pragma unroll 4
        for (int u = 0; u < 16; ++u) { const int dk = dk0 + u; float a = bg[d * 64 + dk];
#pragma unroll
            for (int r = 0; r < 16; r += 4) { const f32x4 w4 = *(const LAS f32x4*)(wg + (d * 64 + dk) * 16 + r); a += z[r] * w4[0] + z[r + 1] * w4[1] + z[r + 2] * w4[2] + z[r + 3] * w4[3]; }
            Bc[(d * 64 + ti) * 65 + dk] = wave_incl_scan(logsigmoid_fast(a) * (1.0f / 16.0f)); } }
    __syncthreads();
    { const unsigned vAw[2] = {vA.x, vA.y}, vBw[2] = {vB.x, vB.y};
#pragma unroll
        for (int e = 0; e < 4; ++e) { VT[(d0 + e) * GP + i] = (bf16_t)((e & 1) ? (vAw[e >> 1] >> 16) : (vAw[e >> 1] & 0xffffu)); VT[(d0 + 16 + e) * GP + i] = (bf16_t)((e & 1) ? (vBw[e >> 1] >> 16) : (vBw[e >> 1] & 0xffffu)); }
#pragma unroll
        for (int d = 0; d < 2; ++d) { const int il = d == 0 ? 63 : 0;
            float qa[4], qb[4], ka[4], kb[4];
#pragma unroll
            for (int e = 0; e < 4; ++e) { const float b1 = Bc[(d * 64 + i) * 65 + d0 + e], b2 = Bc[(d * 64 + i) * 65 + d0 + 16 + e];
                const float l1 = Bc[(d * 64 + il) * 65 + d0 + e], l2 = Bc[(d * 64 + il) * 65 + d0 + 16 + e];
                const float e1 = __expf(b1), e2 = __expf(b2);
                qa[e] = q1[e] * 0.125f * e1; qb[e] = q2[e] * 0.125f * e2; ka[e] = k1[e] * __expf(-b1); kb[e] = k2[e] * __expf(-b2);
                KE[(d * 64 + d0 + e) * GP + i] = (bf16_t)f2bf(k1[e] * __expf(l1 - b1)); KE[(d * 64 + d0 + 16 + e) * GP + i] = (bf16_t)f2bf(k2[e] * __expf(l2 - b2)); }
            u32x2 w; w.x = pk2(qa[0], qa[1]); w.y = pk2(qa[2], qa[3]); *(LAS u32x2*)(QI + (d * 64 + i) * GP + d0) = w;
            w.x = pk2(qb[0], qb[1]); w.y = pk2(qb[2], qb[3]); *(LAS u32x2*)(QI + (d * 64 + i) * GP + d0 + 16) = w;
            w.x = pk2(ka[0], ka[1]); w.y = pk2(ka[2], ka[3]); *(LAS u32x2*)(KI + (d * 64 + i) * GP + d0) = w;
            w.x = pk2(kb[0], kb[1]); w.y = pk2(kb[2], kb[3]); *(LAS u32x2*)(KI + (d * 64 + i) * GP + d0 + 16) = w; } }
    __syncthreads();
    const int d = F.wave >> 2, t4 = F.wave & 3, fr = F.lane & 15, fq = F.lane >> 4;
    const size_t ci = ((size_t)(d * 2 + b) * 4 + h) * NCH + kk;
    const size_t cj = ((size_t)b * NCH + kk) * 4 + h;
    {
        bf16_t* KVp = (bf16_t*)(F.ws + WS_KV) + ci * 4096;
        const LAS bf16_t* ap = KE + (d * 64 + 16 * t4 + fr) * GP + 8 * fq;
        const bf16x8 k0 = *(const LAS bf16x8*)ap, k1f = *(const LAS bf16x8*)(ap + 32);
#pragma unroll
        for (int nt = 0; nt < 4; ++nt) { const LAS bf16_t* bp = VT + (16 * nt + fr) * GP + 8 * fq;
            f32x4 acc = (f32x4){0.f, 0.f, 0.f, 0.f};
            acc = __builtin_amdgcn_mfma_f32_16x16x32_bf16(k0, *(const LAS bf16x8*)bp, acc, 0, 0, 0);
            acc = __builtin_amdgcn_mfma_f32_16x16x32_bf16(k1f, *(const LAS bf16x8*)(bp + 32), acc, 0, 0, 0);
            u32x2 w; w.x = pk2(acc[0], acc[1]); w.y = pk2(acc[2], acc[3]);
            *(u32x2*)(KVp + (16 * nt + fr) * 64 + 16 * t4 + 4 * fq) = w; } }
    if (F.tid < 128) { const int dd = F.tid >> 6, dk = F.tid & 63; const size_t c2 = ((size_t)(dd * 2 + b) * 4 + h) * NCH + kk;
        ((float*)(F.ws + WS_DEC))[c2 * 64 + dk] = expf(Bc[(dd * 64 + (dd == 0 ? 63 : 0)) * 65 + dk]); }
    if (!want_o) { __syncthreads(); return; }
    f32x4 O[4];
    { const int it = t4; const LAS bf16_t* qp = QI + (d * 64 + 16 * it + fr) * GP + 8 * fq;
        const bf16x8 q0 = *(const LAS bf16x8*)qp, q1f = *(const LAS bf16x8*)(qp + 32);
        { bf16_t* qg = (bf16_t*)(F.ws + WS_QIG) + (((cj * 2 + d) * 4 + it) * 64 + F.lane) * 16; *(bf16x8*)qg = q0; *(bf16x8*)(qg + 8) = q1f; }
        const int ig = 16 * it + fr;
        bf16x8 pf[2];
#pragma unroll
        for (int s = 0; s < 2; ++s) { f32x4 at[2];
#pragma unroll
            for (int t = 0; t < 2; ++t) { const int jrow = 32 * s + 8 * (fr >> 2) + (fr & 3) + 4 * t;
                const LAS bf16_t* kp = KI + (d * 64 + jrow) * GP + 8 * fq;
                f32x4 acc = (f32x4){0.f, 0.f, 0.f, 0.f};
                acc = __builtin_amdgcn_mfma_f32_16x16x32_bf16(*(const LAS bf16x8*)kp, q0, acc, 0, 0, 0);
                acc = __builtin_amdgcn_mfma_f32_16x16x32_bf16(*(const LAS bf16x8*)(kp + 32), q1f, acc, 0, 0, 0);
#pragma unroll
                for (int j = 0; j < 4; ++j) { const int jj = 32 * s + 8 * fq + 4 * t + j; const bool ok = d == 0 ? (jj <= ig) : (jj >= ig); acc[j] = ok ? acc[j] : 0.f; }
                at[t] = acc; }
            u32x4 pw; pw.x = pg8::cvt_pk_bf16(at[0][0], at[0][1]); pw.y = pg8::cvt_pk_bf16(at[0][2], at[0][3]); pw.z = pg8::cvt_pk_bf16(at[1][0], at[1][1]); pw.w = pg8::cvt_pk_bf16(at[1][2], at[1][3]);
            pf[s] = __builtin_bit_cast(bf16x8, pw); }
#pragma unroll
        for (int dt = 0; dt < 4; ++dt) { f32x4 acc = (f32x4){0.f, 0.f, 0.f, 0.f};
            const LAS bf16_t* vp = VT + (16 * dt + fr) * GP + 8 * fq;
            acc = __builtin_amdgcn_mfma_f32_16x16x32_bf16(*(const LAS bf16x8*)vp, pf[0], acc, 0, 0, 0);
            acc = __builtin_amdgcn_mfma_f32_16x16x32_bf16(*(const LAS bf16x8*)(vp + 32), pf[1], acc, 0, 0, 0);
            O[dt] = acc; } }
    LAS float* om = OM + (t4 * 64 + F.lane) * 16;
    if (d == 1) {
#pragma unroll
        for (int dt = 0; dt < 4; ++dt) *(LAS f32x4*)(om + 4 * dt) = O[dt]; }
    __syncthreads();
    if (d == 0) { bf16_t* og = (bf16_t*)(F.ws + WS_OI) + ((cj * 4 + t4) * 64 + F.lane) * 16;
        u32x4 w0, w1; f32x4 s0 = O[0] + *(const LAS f32x4*)(om + 0), s1 = O[1] + *(const LAS f32x4*)(om + 4), s2 = O[2] + *(const LAS f32x4*)(om + 8), s3 = O[3] + *(const LAS f32x4*)(om + 12);
        w0.x = pk2(s0[0], s0[1]); w0.y = pk2(s0[2], s0[3]); w0.z = pk2(s1[0], s1[1]); w0.w = pk2(s1[2], s1[3]);
        w1.x = pk2(s2[0], s2[1]); w1.y = pk2(s2[2], s2[3]); w1.z = pk2(s3[0], s3[1]); w1.w = pk2(s3[2], s3[3]);
        *(u32x4*)og = w0; *(u32x4*)(og + 8) = w1; }
    __syncthreads();
}
__device__ __forceinline__ void t_gla_fin(Frame& F, const Args& A, int l, int task, bool need_ctx) {
    const int h = task & 3, kk = (task >> 2) % NCH, b = task / (4 * NCH);
    if (kk < 4 && !need_ctx) return;
    const int row0 = chunk_row0(b, kk);
    LAS float* OM = (LAS float*)F.lds;
    const int d = F.wave >> 2, it = F.wave & 3, fr = F.lane & 15, fq = F.lane >> 4;
    const size_t ci = ((size_t)(d * 2 + b) * 4 + h) * NCH + kk, cj = ((size_t)b * NCH + kk) * 4 + h;
    const bf16_t* qg = (const bf16_t*)(F.ws + WS_QIG) + (((cj * 2 + d) * 4 + it) * 64 + F.lane) * 16;
    const bf16x8 q0 = *(const bf16x8*)qg, q1 = *(const bf16x8*)(qg + 8);
    const bf16_t* Sp = (const bf16_t*)(F.ws + WS_SS) + ci * 4096;
    f32x4 oi[4];
    const int row = row0 + 16 * it + fr;
    u32x2 gw[4];
    if (d == 0) { const float* og = (const float*)(F.ws + WS_OI) + ((cj * 4 + it) * 64 + F.lane) * 16;
        const bf16_t* ogate = (const bf16_t*)(F.ws + WS_P) + (size_t)row * PC + C_OG + h * 64 + 4 * fq;
#pragma unroll
        for (int dt = 0; dt < 4; ++dt) { oi[dt] = *(const f32x4*)(og + 4 * dt); gw[dt] = *(const u32x2*)(ogate + 16 * dt); } }
    f32x4 O[4];
    bf16x8 sv[8];
#pragma unroll
    for (int dt = 0; dt < 4; ++dt) { const bf16_t* sp = Sp + (16 * dt + fr) * 64 + 8 * fq; sv[dt * 2] = *(const bf16x8*)sp; sv[dt * 2 + 1] = *(const bf16x8*)(sp + 32); }
    asm volatile("" : "+v"(sv[0]), "+v"(sv[1]), "+v"(sv[2]), "+v"(sv[3]), "+v"(sv[4]), "+v"(sv[5]), "+v"(sv[6]), "+v"(sv[7]) :: "memory");
#pragma unroll
    for (int dt = 0; dt < 4; ++dt) { f32x4 acc = (f32x4){0.f, 0.f, 0.f, 0.f};
        acc = __builtin_amdgcn_mfma_f32_16x16x32_bf16(sv[dt * 2], q0, acc, 0, 0, 0);
        acc = __builtin_amdgcn_mfma_f32_16x16x32_bf16(sv[dt * 2 + 1], q1, acc, 0, 0, 0);
        O[dt] = acc; }
    LAS float* om = OM + (it * 64 + F.lane) * 16;
    if (d == 1) {
#pragma unroll
        for (int dt = 0; dt < 4; ++dt) *(LAS f32x4*)(om + 4 * dt) = O[dt]; }
    __syncthreads();
    if (d == 0) {
        float sq = 0.f;
#pragma unroll
        for (int dt = 0; dt < 4; ++dt) { O[dt] = O[dt] + *(const LAS f32x4*)(om + 4 * dt) + oi[dt]; sq += (O[dt][0] * O[dt][0] + O[dt][1] * O[dt][1]) + (O[dt][2] * O[dt][2] + O[dt][3] * O[dt][3]); }
        sq += __shfl_xor(sq, 16); sq += __shfl_xor(sq, 32);
        const float rstd = 1.0f / sqrtf(sq * (1.0f / 64.0f) + EPS);
        const float* gn = INP(I_GNG) + l * 64 + 4 * fq;
        bf16_t* mo = (bf16_t*)(F.ws + WS_MIX) + (size_t)row * D + h * 64 + 4 * fq;
#pragma unroll
        for (int dt = 0; dt < 4; ++dt) { const f32x4 g4 = *(const f32x4*)(gn + 16 * dt);
            const float o0 = O[dt][0] * rstd * g4[0] * silu_fast(bf2f(gw[dt].x & 0xffffu)), o1 = O[dt][1] * rstd * g4[1] * silu_fast(bf2f(gw[dt].x >> 16));
            const float o2 = O[dt][2] * rstd * g4[2] * silu_fast(bf2f(gw[dt].y & 0xffffu)), o3 = O[dt][3] * rstd * g4[3] * silu_fast(bf2f(gw[dt].y >> 16));
            u32x2 w; w.x = pk2(o0, o1); w.y = pk2(o2, o3);
            *(u32x2*)(mo + 16 * dt) = w; }
    }
    __syncthreads();
}


__device__ __forceinline__ void t_gla_fin_wave(Frame& F, const Args& A, int l, int wt, bool need_ctx) {
    const int it = wt & 3, h = (wt >> 2) & 3, kk = (wt >> 4) % NCH, b = wt / (16 * NCH);
    if (kk < 4 && !need_ctx) return;
    const int row0 = chunk_row0(b, kk), fr = F.lane & 15, fq = F.lane >> 4;
    const size_t cj = ((size_t)b * NCH + kk) * 4 + h;
    const int row = row0 + 16 * it + fr;
    f32x4 O[4]; u32x2 gw[4]; bf16x8 qf[4], sv[16]; f32x4 g4[4];
    { const float* gn = INP(I_GNG) + l * 64 + 4 * fq;
#pragma unroll
        for (int dt = 0; dt < 4; ++dt) g4[dt] = *(const f32x4*)(gn + 16 * dt); }
    u32x4 oraw[2];
    { const bf16_t* og = (const bf16_t*)(F.ws + WS_OI) + ((cj * 4 + it) * 64 + F.lane) * 16;
        const bf16_t* ogate = (const bf16_t*)(F.ws + WS_P) + (size_t)row * PC + C_OG + h * 64 + 4 * fq;
        oraw[0] = *(const u32x4*)og; oraw[1] = *(const u32x4*)(og + 8);
#pragma unroll
        for (int dt = 0; dt < 4; ++dt) gw[dt] = *(const u32x2*)(ogate + 16 * dt); }
#pragma unroll
    for (int d = 0; d < 2; ++d) { const size_t ci = ((size_t)(d * 2 + b) * 4 + h) * NCH + kk;
        const bf16_t* qg = (const bf16_t*)(F.ws + WS_QIG) + (((cj * 2 + d) * 4 + it) * 64 + F.lane) * 16;
        qf[d * 2] = *(const bf16x8*)qg; qf[d * 2 + 1] = *(const bf16x8*)(qg + 8);
        const bf16_t* Sp = (const bf16_t*)(F.ws + WS_SS) + ci * 4096;
#pragma unroll
        for (int dt = 0; dt < 4; ++dt) { const bf16_t* sp = Sp + (16 * dt + fr) * 64 + 8 * fq; sv[d * 8 + dt * 2] = *(const bf16x8*)sp; sv[d * 8 + dt * 2 + 1] = *(const bf16x8*)(sp + 32); } }
    asm volatile("" : "+v"(sv[0]), "+v"(sv[1]), "+v"(sv[2]), "+v"(sv[3]), "+v"(sv[4]), "+v"(sv[5]), "+v"(sv[6]), "+v"(sv[7]),
                      "+v"(sv[8]), "+v"(sv[9]), "+v"(sv[10]), "+v"(sv[11]), "+v"(sv[12]), "+v"(sv[13]), "+v"(sv[14]), "+v"(sv[15]) :: "memory");
    asm volatile("" : "+v"(oraw[0]), "+v"(oraw[1]) :: "memory");
    O[0] = (f32x4){bf2f(oraw[0].x & 0xffffu), bf2f(oraw[0].x >> 16), bf2f(oraw[0].y & 0xffffu), bf2f(oraw[0].y >> 16)};
    O[1] = (f32x4){bf2f(oraw[0].z & 0xffffu), bf2f(oraw[0].z >> 16), bf2f(oraw[0].w & 0xffffu), bf2f(oraw[0].w >> 16)};
    O[2] = (f32x4){bf2f(oraw[1].x & 0xffffu), bf2f(oraw[1].x >> 16), bf2f(oraw[1].y & 0xffffu), bf2f(oraw[1].y >> 16)};
    O[3] = (f32x4){bf2f(oraw[1].z & 0xffffu), bf2f(oraw[1].z >> 16), bf2f(oraw[1].w & 0xffffu), bf2f(oraw[1].w >> 16)};
    asm volatile("" : "+v"(qf[0]), "+v"(qf[1]), "+v"(qf[2]), "+v"(qf[3]), "+v"(O[0]), "+v"(O[1]), "+v"(O[2]), "+v"(O[3]), "+v"(g4[0]), "+v"(g4[1]), "+v"(g4[2]), "+v"(g4[3]), "+v"(gw[0]), "+v"(gw[1]), "+v"(gw[2]), "+v"(gw[3]));
#pragma unroll
    for (int d = 0; d < 2; ++d)
#pragma unroll
        for (int dt = 0; dt < 4; ++dt) {
            O[dt] = __builtin_amdgcn_mfma_f32_16x16x32_bf16(sv[d * 8 + dt * 2], qf[d * 2], O[dt], 0, 0, 0);
            O[dt] = __builtin_amdgcn_mfma_f32_16x16x32_bf16(sv[d * 8 + dt * 2 + 1], qf[d * 2 + 1], O[dt], 0, 0, 0); }
    float sq = 0.f;
#pragma unroll
    for (int dt = 0; dt < 4; ++dt) sq += (O[dt][0] * O[dt][0] + O[dt][1] * O[dt][1]) + (O[dt][2] * O[dt][2] + O[dt][3] * O[dt][3]);
    sq += __shfl_xor(sq, 16); sq += __shfl_xor(sq, 32);
    const float rstd = 1.0f / sqrtf(sq * (1.0f / 64.0f) + EPS);
    bf16_t* mo = (bf16_t*)(F.ws + WS_MIX) + (size_t)row * D + h * 64 + 4 * fq;
#pragma unroll
    for (int dt = 0; dt < 4; ++dt) {
        const float o0 = O[dt][0] * rstd * g4[dt][0] * silu_fast(bf2f(gw[dt].x & 0xffffu)), o1 = O[dt][1] * rstd * g4[dt][1] * silu_fast(bf2f(gw[dt].x >> 16));
        const float o2 = O[dt][2] * rstd * g4[dt][2] * silu_fast(bf2f(gw[dt].y & 0xffffu)), o3 = O[dt][3] * rstd * g4[dt][3] * silu_fast(bf2f(gw[dt].y >> 16));
        u32x2 w; w.x = pk2(o0, o1); w.y = pk2(o2, o3);
        *(u32x2*)(mo + 16 * dt) = w; }
}

__device__ __forceinline__ void t_gmlp_mfma(Frame& F, const Args& A, int l, int task, bool need_ctx) {
    const int g = task & 3, cq = task >> 2;
    if (cq >= 128 && !need_ctx) return;
    const int row0 = cq < 128 ? (cq >> 6) * SEQ + (cq & 63) * 128 : NLAT + ((cq - 128) >> 1) * CTX + ((cq - 128) & 1) * 128;
    const bf16_t* P = (const bf16_t*)(F.ws + WS_P);
    constexpr int WP = 136;
    LAS bf16_t* W16 = (LAS bf16_t*)F.lds;
    LAS bf16_t* VNT = W16 + 128 * WP;
    LAS float* rs = (LAS float*)(VNT + 64 * WP);
    const float* gnorm = INP(I_MNG) + l * 256;
    const int fr = F.lane & 15, fq = F.lane >> 4, itok = 16 * F.wave + fr;
    const int jp = F.tid >> 3, c = F.tid & 7, j = 2 * jp;
    u32x2 rw[16]; f32x4 wv[8]; u32x4 vv[2]; f32x4 gq[2]; u32x2 gwv[4]; float bsv;
#pragma unroll
    for (int u = 0; u < 16; ++u) rw[u] = *(const u32x2*)(P + (size_t)(row0 + F.wave * 16 + u) * PC + C_GV + 4 * F.lane);
    const float* wsrc = INP(I_MWS) + (size_t)(l * 4 + g) * 128 * 128;
#pragma unroll
    for (int u = 0; u < 4; ++u) { const int idx = F.tid + 512 * u, i = idx >> 4, j8 = (idx & 15) * 8; wv[2 * u] = *(const f32x4*)(wsrc + i * 128 + j8); wv[2 * u + 1] = *(const f32x4*)(wsrc + i * 128 + j8 + 4); }
    { const bf16_t* vp = P + (size_t)(row0 + j) * PC + C_GV + g * 64 + 8 * c; vv[0] = *(const u32x4*)vp; vv[1] = *(const u32x4*)(vp + PC); }
    gq[0] = *(const f32x4*)(gnorm + g * 64 + 8 * c); gq[1] = *(const f32x4*)(gnorm + g * 64 + 8 * c + 4);
    const bf16_t* gu = P + (size_t)(row0 + itok) * PC + C_GU + g * 64 + 4 * fq;
#pragma unroll
    for (int dt = 0; dt < 4; ++dt) gwv[dt] = *(const u32x2*)(gu + 16 * dt);
    bsv = INP(I_MBS)[(size_t)(l * 4 + g) * 128 + itok];
    pin16(rw); pin8(wv); pin2(vv); pin2(gq); pin4(gwv); pin1(bsv);
#pragma unroll
    for (int u = 0; u < 16; ++u) { const u32x2 w = rw[u];
        const float a = bf2f(w.x & 0xffffu), b2 = bf2f(w.x >> 16), c2 = bf2f(w.y & 0xffffu), d2 = bf2f(w.y >> 16);
        const float ssum = wave_sum(a * a + b2 * b2 + c2 * c2 + d2 * d2);
        if (F.lane == 0) rs[F.wave * 16 + u] = 1.0f / sqrtf(ssum * (1.0f / 256.0f) + EPS);
    }
    {
#pragma unroll
        for (int u = 0; u < 4; ++u) { const int idx = F.tid + 512 * u, i = idx >> 4, j8 = (idx & 15) * 8; const f32x4 v0 = wv[2 * u], v1 = wv[2 * u + 1];
            u32x4 o; o.x = pk2(v0[0], v0[1]); o.y = pk2(v0[2], v0[3]); o.z = pk2(v1[0], v1[1]); o.w = pk2(v1[2], v1[3]);
            *(LAS u32x4*)(W16 + i * WP + j8) = o; } }
    __syncthreads();
    { const u32x4 v0 = vv[0], v1 = vv[1];
        const float r0 = rs[j], r1 = rs[j + 1];
        const unsigned a0[4] = {v0.x, v0.y, v0.z, v0.w}, a1[4] = {v1.x, v1.y, v1.z, v1.w};
#pragma unroll
        for (int u = 0; u < 8; ++u) { const int dd = 8 * c + u; const float gn = gq[u >> 2][u & 3];
            const float x0 = bf2f((u & 1) ? (a0[u >> 1] >> 16) : (a0[u >> 1] & 0xffffu)) * r0 * gn, x1 = bf2f((u & 1) ? (a1[u >> 1] >> 16) : (a1[u >> 1] & 0xffffu)) * r1 * gn;
            *(LAS unsigned*)(VNT + dd * WP + j) = pk2(x0, x1); } }
    __syncthreads();
    bf16x8 bw[4];
#pragma unroll
    for (int ks = 0; ks < 4; ++ks) bw[ks] = *(const LAS bf16x8*)(W16 + itok * WP + 8 * fq + 32 * ks);
    bf16_t* mo = (bf16_t*)(F.ws + WS_MIX) + (size_t)(row0 + itok) * D + 256 + g * 64 + 4 * fq;
#pragma unroll
    for (int dt = 0; dt < 4; ++dt) { f32x4 acc = (f32x4){0.f, 0.f, 0.f, 0.f};
#pragma unroll
        for (int ks = 0; ks < 4; ++ks) acc = __builtin_amdgcn_mfma_f32_16x16x32_bf16(*(const LAS bf16x8*)(VNT + (16 * dt + fr) * WP + 8 * fq + 32 * ks), bw[ks], acc, 0, 0, 0);
        const u32x2 gw = gwv[dt];
        u32x2 w; w.x = pk2(bf2f(gw.x & 0xffffu) * (acc[0] + bsv), bf2f(gw.x >> 16) * (acc[1] + bsv)); w.y = pk2(bf2f(gw.y & 0xffffu) * (acc[2] + bsv), bf2f(gw.y >> 16) * (acc[3] + bsv));
        *(u32x2*)(mo + 16 * dt) = w; }
    __syncthreads();
}

__device__ __forceinline__ int lru_task_row0(int task, int& s, int& ch, int& len, int& b, int& kk) {
    if (task < 256) { b = task >> 7; ch = task & 127; s = b; len = SEQ; kk = 4 + ch; return b * SEQ + ch * 64; }
    const int q = task - 256; b = q >> 2; ch = q & 3; s = 2 + b; len = CTX; kk = ch; return NLAT + b * CTX + ch * 64;
}
__device__ __forceinline__ void t_lru_half(Frame& F, const Args& A, int l, int task) {
    const int ch2 = task & 1; int s, ch, len, b, kk; const int row0 = lru_task_row0(task >> 1, s, ch, len, b, kk);
    const bf16_t* P = (const bf16_t*)(F.ws + WS_P);
    constexpr int XP = 136;
    LAS bf16_t* xcb = (LAS bf16_t*)F.lds;
    constexpr int ABP = 132;
    LAS float* ab = (LAS float*)(F.lds + 64 * XP * 2);
    const int cbase = 128 * ch2;
    const float* cw = INP(I_LCW) + (size_t)l * 4 * 256 + cbase; const float* cb = INP(I_LCB) + (size_t)l * 256 + cbase;
    const int d = F.wave >> 2, g2 = (F.wave >> 1) & 1, tt2 = F.wave & 1, g = 2 * ch2 + g2, fr = F.lane & 15, fq = F.lane >> 4;
    const bf16_t* WT = (const bf16_t*)(F.ws + WS_LRUW);
    f32x2 cwv[5]; float gc[12];
    bf16x8 wf[16];
    { unsigned w[8][4];
#pragma unroll
        for (int u = 0; u < 8; ++u) { const int idx = F.tid + 512 * u, t = idx >> 6, c = (idx & 63) * 2;
#pragma unroll
            for (int j = 0; j < 4; ++j) { const int tt = ch * 64 + t + j - 2; w[u][j] = 0u;
                if (tt >= 0 && tt < len) w[u][j] = *(const unsigned*)(P + (size_t)(row0 + t + j - 2) * PC + C_LX + cbase + c); } }
        { const int c = (F.tid & 63) * 2; cwv[0] = *(const f32x2*)(cb + c);
#pragma unroll
            for (int j = 0; j < 4; ++j) cwv[1 + j] = *(const f32x2*)(cw + j * 256 + c); }
        { const float* pbr = INP(I_LBR) + (size_t)(l * 2 + d) * 256 + 64 * g + fr; const float* pbi = INP(I_LBI) + (size_t)(l * 2 + d) * 256 + 64 * g + fr; const float* plm = INP(I_LLAM) + (size_t)(l * 2 + d) * 256 + 64 * g + fr;
#pragma unroll
            for (int nt = 0; nt < 4; ++nt) { gc[nt] = pbr[16 * nt]; gc[4 + nt] = pbi[16 * nt]; gc[8 + nt] = plm[16 * nt]; } }
#pragma unroll
        for (int nt = 0; nt < 4; ++nt) {
            const bf16_t* wr = WT + ((size_t)(((l * 2 + d) * 2 + 0) * 4 + g) * 64 + 16 * nt + fr) * 64 + 8 * fq;
            const bf16_t* wi = WT + ((size_t)(((l * 2 + d) * 2 + 1) * 4 + g) * 64 + 16 * nt + fr) * 64 + 8 * fq;
            wf[nt * 4 + 0] = *(const bf16x8*)wr; wf[nt * 4 + 1] = *(const bf16x8*)(wr + 32); wf[nt * 4 + 2] = *(const bf16x8*)wi; wf[nt * 4 + 3] = *(const bf16x8*)(wi + 32); }
        asm volatile("" : "+v"(w[0][0]), "+v"(w[0][1]), "+v"(w[0][2]), "+v"(w[0][3]), "+v"(w[1][0]), "+v"(w[1][1]), "+v"(w[1][2]), "+v"(w[1][3]),
                          "+v"(w[2][0]), "+v"(w[2][1]), "+v"(w[2][2]), "+v"(w[2][3]), "+v"(w[3][0]), "+v"(w[3][1]), "+v"(w[3][2]), "+v"(w[3][3]) :: "memory");
        asm volatile("" : "+v"(w[4][0]), "+v"(w[4][1]), "+v"(w[4][2]), "+v"(w[4][3]), "+v"(w[5][0]), "+v"(w[5][1]), "+v"(w[5][2]), "+v"(w[5][3]),
                          "+v"(w[6][0]), "+v"(w[6][1]), "+v"(w[6][2]), "+v"(w[6][3]), "+v"(w[7][0]), "+v"(w[7][1]), "+v"(w[7][2]), "+v"(w[7][3]) :: "memory");
        asm volatile("" : "+v"(cwv[0]), "+v"(cwv[1]), "+v"(cwv[2]), "+v"(cwv[3]), "+v"(cwv[4]) :: "memory");
        pin12(gc);
#pragma unroll
        for (int u = 0; u < 8; ++u) { const int idx = F.tid + 512 * u, t = idx >> 6, c = (idx & 63) * 2; float a0 = cwv[0][0], a1 = cwv[0][1];
#pragma unroll
            for (int j = 0; j < 4; ++j) { a0 += cwv[1 + j][0] * bf2f(w[u][j] & 0xffffu); a1 += cwv[1 + j][1] * bf2f(w[u][j] >> 16); }
            *(LAS unsigned*)(xcb + t * XP + c) = pk2(a0, a1); } }
    float br[4], bi[4], sp[4];
#pragma unroll
    for (int nt = 0; nt < 4; ++nt) { br[nt] = gc[nt]; bi[nt] = gc[4 + nt];
        { const float xl = -gc[8 + nt]; sp[nt] = fmaxf(xl, 0.f) + __logf(1.0f + __expf(-fabsf(xl))); } }
    const int sd = F.tid >> 7, sc = F.tid & 127;
    float hcur = 0.f, pa = 1.f;
    asm volatile("" : "+v"(wf[0]), "+v"(wf[1]), "+v"(wf[2]), "+v"(wf[3]), "+v"(wf[4]), "+v"(wf[5]), "+v"(wf[6]), "+v"(wf[7]),
                      "+v"(wf[8]), "+v"(wf[9]), "+v"(wf[10]), "+v"(wf[11]), "+v"(wf[12]), "+v"(wf[13]), "+v"(wf[14]), "+v"(wf[15]) :: "memory");
    __syncthreads();
    for (int hf = 0; hf < 2; ++hf) {
        { const int t0 = (d == 0 ? hf : 1 - hf) * 32;
            const LAS bf16_t* ap = xcb + (t0 + 16 * tt2 + fr) * XP + 64 * g2 + 8 * fq;
            const bf16x8 a0 = *(const LAS bf16x8*)ap, a1 = *(const LAS bf16x8*)(ap + 32);
            unsigned xw[16];
#pragma unroll
            for (int u = 0; u < 16; ++u) xw[u] = xcb[(t0 + 16 * tt2 + 4 * fq + (u & 3)) * XP + 64 * g2 + 16 * (u >> 2) + fr];
            pin16(xw);
#pragma unroll
            for (int nt = 0; nt < 4; ++nt) {
                f32x4 ar = (f32x4){0.f, 0.f, 0.f, 0.f}, ai = ar;
                ar = __builtin_amdgcn_mfma_f32_16x16x32_bf16(a0, wf[nt * 4 + 0], ar, 0, 0, 0);
                ar = __builtin_amdgcn_mfma_f32_16x16x32_bf16(a1, wf[nt * 4 + 1], ar, 0, 0, 0);
                ai = __builtin_amdgcn_mfma_f32_16x16x32_bf16(a0, wf[nt * 4 + 2], ai, 0, 0, 0);
                ai = __builtin_amdgcn_mfma_f32_16x16x32_bf16(a1, wf[nt * 4 + 3], ai, 0, 0, 0);
                const int ccl = 64 * g2 + 16 * nt + fr;
#pragma unroll
                for (int j = 0; j < 4; ++j) { const int tl = 16 * tt2 + 4 * fq + j;
                    const float dr = 1.0f + __expf(fminf(-(ar[j] + br[nt]), 40.0f)), di = 1.0f + __expf(fminf(-(ai[j] + bi[nt]), 40.0f));
                    const float inv = __builtin_amdgcn_rcpf(dr * di), r = di * inv, ig = dr * inv;
                    const float log_a = -8.0f * r * sp[nt], av = __expf(log_a), x2 = 2.0f * log_a;
                    const float om = x2 > -0.03f ? -x2 * (1.0f + x2 * (0.5f + x2 * (1.0f / 6.0f))) : 1.0f - av * av;
                    const float xv = bf2f(xw[nt * 4 + j]);
                    ab[((d * 2 + 0) * 32 + tl) * ABP + ccl] = av; ab[((d * 2 + 1) * 32 + tl) * ABP + ccl] = __builtin_sqrtf(om) * (ig * xv); } } }
        __syncthreads();
        if (F.tid < 256) { const int st0 = (sd == 0 ? hf : 1 - hf) * 32;
            bf16_t* LH = (bf16_t*)(F.ws + WS_LH) + (size_t)sd * MROWS * 256 + cbase + sc; bf16_t* LA = (bf16_t*)(F.ws + WS_LA) + (size_t)sd * MROWS * 256 + cbase + sc;
#pragma unroll 1
            for (int n0 = 0; n0 < 32; n0 += 8) {
                float avs[16];
#pragma unroll
                for (int u = 0; u < 8; ++u) { const int tl = sd == 0 ? n0 + u : 31 - (n0 + u); avs[u] = ab[((sd * 2 + 0) * 32 + tl) * ABP + sc]; avs[8 + u] = ab[((sd * 2 + 1) * 32 + tl) * ABP + sc]; }
                pin16(avs);
#pragma unroll
                for (int u = 0; u < 8; ++u) { const int tl = sd == 0 ? n0 + u : 31 - (n0 + u);
                    hcur = avs[u] * hcur + avs[8 + u]; pa *= avs[u];
                    LH[(size_t)(row0 + st0 + tl) * 256] = (bf16_t)f2bf(hcur); LA[(size_t)(row0 + st0 + tl) * 256] = (bf16_t)f2bf(pa); } } }
        __syncthreads();
    }
    if (F.tid < 256) { const size_t si = ((size_t)(sd * 2 + b) * NCH + kk) * 256 + cbase + sc;
        ((float*)(F.ws + WS_LSA))[si] = pa; ((float*)(F.ws + WS_LSH))[si] = hcur; }
    __syncthreads();
}
__device__ __forceinline__ void t_lru_scan(Frame& F, int task, bool dry = false) {
    const int e = task * 512 + F.tid; const int c = e & 255, db = e >> 8, d = db >> 1;
    const float* SA = (const float*)(F.ws + WS_LSA) + (size_t)db * NCH * 256 + c; const float* SH = (const float*)(F.ws + WS_LSH) + (size_t)db * NCH * 256 + c;
    float* LC = (float*)(F.ws + WS_LC) + (size_t)db * NCH * 256 + c;
    float hc = 0.f;
    for (int n0 = 0; n0 < NCH; n0 += 22) {
        float a[22], hh[22]; int idx[22];
#pragma unroll
        for (int u = 0; u < 22; ++u) { const int n = n0 + u; idx[u] = d == 0 ? n : (n < 4 ? 3 - n : NCH - 1 - (n - 4)); a[u] = SA[idx[u] * 256]; hh[u] = SH[idx[u] * 256]; }
#pragma unroll
        for (int u = 0; u < 22; ++u) { (dry ? LC + (WS_HID - WS_LC) / 4 : LC)[idx[u] * 256] = hc; hc = a[u] * hc + hh[u]; }
    }
}
__device__ __forceinline__ void t_lru_fix(Frame& F, int task, bool need_ctx) {
    int s, ch, len, b, kk; const int row0 = lru_task_row0(task, s, ch, len, b, kk);
    if (task >= 256 && !need_ctx) return;
    const bf16_t* P = (const bf16_t*)(F.ws + WS_P);
    const bf16_t* LH = (const bf16_t*)(F.ws + WS_LH); const bf16_t* LA = (const bf16_t*)(F.ws + WS_LA); const float* LC = (const float*)(F.ws + WS_LC);
    bf16_t* MIX = (bf16_t*)(F.ws + WS_MIX);
    const bf16_t* LH1 = LH + (size_t)MROWS * 256; const bf16_t* LA1 = LA + (size_t)MROWS * 256;
    const float* c0p = LC + ((size_t)(0 * 2 + b) * NCH + kk) * 256; const float* c1p = LC + ((size_t)(1 * 2 + b) * NCH + kk) * 256;
#pragma unroll 1
    for (int half = 0; half < 2; ++half) {
        u32x2 h0[4], a0[4], h1[4], a1[4]; f32x4 r0[4], r1[4]; u32x2 yw[4];
#pragma unroll
        for (int u = 0; u < 4; ++u) { const int idx = F.tid + 512 * (half * 4 + u), t = idx >> 6, c4 = (idx & 63) * 4; const size_t ro = (size_t)(row0 + t) * 256 + c4;
            h0[u] = *(const u32x2*)(LH + ro); a0[u] = *(const u32x2*)(LA + ro); h1[u] = *(const u32x2*)(LH1 + ro); a1[u] = *(const u32x2*)(LA1 + ro);
            r0[u] = *(const f32x4*)(c0p + c4); r1[u] = *(const f32x4*)(c1p + c4); yw[u] = *(const u32x2*)(P + (size_t)(row0 + t) * PC + C_LY + c4); }
        asm volatile("" : "+v"(h0[0]), "+v"(h0[1]), "+v"(h0[2]), "+v"(h0[3]), "+v"(a0[0]), "+v"(a0[1]), "+v"(a0[2]), "+v"(a0[3]),
                          "+v"(h1[0]), "+v"(h1[1]), "+v"(h1[2]), "+v"(h1[3]), "+v"(a1[0]), "+v"(a1[1]), "+v"(a1[2]), "+v"(a1[3]) :: "memory");
#pragma unroll
        for (int u = 0; u < 4; ++u) { const int idx = F.tid + 512 * (half * 4 + u), t = idx >> 6, c4 = (idx & 63) * 4;
            const f32x4 H0 = (f32x4){bf2f(h0[u].x & 0xffffu), bf2f(h0[u].x >> 16), bf2f(h0[u].y & 0xffffu), bf2f(h0[u].y >> 16)}, A0 = (f32x4){bf2f(a0[u].x & 0xffffu), bf2f(a0[u].x >> 16), bf2f(a0[u].y & 0xffffu), bf2f(a0[u].y >> 16)};
            const f32x4 H1 = (f32x4){bf2f(h1[u].x & 0xffffu), bf2f(h1[u].x >> 16), bf2f(h1[u].y & 0xffffu), bf2f(h1[u].y >> 16)}, A1 = (f32x4){bf2f(a1[u].x & 0xffffu), bf2f(a1[u].x >> 16), bf2f(a1[u].y & 0xffffu), bf2f(a1[u].y >> 16)};
            const f32x4 hs = (H0 + A0 * r0[u]) + (H1 + A1 * r1[u]);
            const float y0 = bf2f(yw[u].x & 0xffffu), y1 = bf2f(yw[u].x >> 16), y2 = bf2f(yw[u].y & 0xffffu), y3 = bf2f(yw[u].y >> 16);
            u32x2 o; o.x = pk2(hs[0] * gelu_tanh(y0), hs[1] * gelu_tanh(y1)); o.y = pk2(hs[2] * gelu_tanh(y2), hs[3] * gelu_tanh(y3));
            *(u32x2*)(MIX + (size_t)(row0 + t) * D + 512 + c4) = o; }
    }
}


__device__ __forceinline__ void t_nat_mfma(Frame& F, const Args& A, int l, int task, bool need_ctx) {
    const bool isctx = task >= 1024;
    if (isctx && !need_ctx) return;
    int b, r, h, qrow0;
    if (!isctx) { h = task & 3; r = (task >> 2) & 127; b = task >> 9; qrow0 = b * SEQ + r * 64; }
    else { const int q = task - 1024; h = q & 3; r = (q >> 2) & 3; b = q >> 4; qrow0 = NLAT + b * CTX + r * 64; }
    const bf16_t* P = (const bf16_t*)(F.ws + WS_P);
    constexpr int VP = 776;
    LAS unsigned* VT32 = (LAS unsigned*)F.lds;
    LAS float* rp = (LAS float*)(F.lds + 64 * VP * 2);
    LAS float* mg = rp + 512;
    constexpr int KP = 72;
    LAS bf16_t* KC = (LAS bf16_t*)(mg + 4 * 64 * 18);
    const int crow0 = NLAT + b * CTX;
    const int r0 = r - 4 < 0 ? 0 : (r - 4 > 120 ? 120 : r - 4);
    const int n = F.wave & 3, half = F.wave >> 2, fr = F.lane & 15, g = F.lane >> 4;
    const int band0 = n == 0 ? 0 : (n == 1 ? 8 : (n == 2 ? 24 : 32));
    const int qcol = 16 * n + fr, c0q = qcol - 8 < 0 ? 0 : (qcol - 8 > 48 ? 48 : qcol - 8);
    const bool active = !(isctx && half == 0);
    const int koff = 8 * (fr >> 2) + (fr & 3);
    bf16x8 q0, q1, kfa[16], kfb[16];
    { u32x4 va[6], vb[6], kc[4]; float rpv = 0.f;
#pragma unroll
        for (int u = 0; u < 6; ++u) { const int it = F.tid + 512 * u, c = it & 7, kp = it >> 3, k0 = 2 * kp;
            if (isctx && u < 4) continue;
            const int row = k0 < 512 ? b * SEQ + (r0 + (k0 >> 6)) * 64 + (k0 & 63) : crow0 + (k0 - 512);
            const bf16_t* vp = P + (size_t)row * PC + C_NV + h * 64 + 8 * c;
            va[u] = *(const u32x4*)vp; vb[u] = *(const u32x4*)(vp + PC); }
#pragma unroll
        for (int u = 0; u < 4; ++u) { const int idx = F.tid + 512 * u, key = idx >> 3, c = idx & 7; kc[u] = *(const u32x4*)(P + (size_t)(crow0 + key) * PC + C_NK + h * 64 + 8 * c); }
        if (!isctx && F.tid < 15 * 31) rpv = INP(I_RPB)[(size_t)(l * 4 + h) * 15 * 31 + F.tid];
        if (active) { const bf16_t* qp = P + (size_t)(qrow0 + 16 * n + fr) * PC + C_NQ + h * 64 + 8 * g; q0 = *(const bf16x8*)qp; q1 = *(const bf16x8*)(qp + 32); }
        if (active && half == 0) {
#pragma unroll
            for (int s = 0; s < 4; ++s)
#pragma unroll
                for (int t = 0; t < 2; ++t) { const bf16_t* kp = P + (size_t)(b * SEQ + (r0 + s) * 64 + band0 + koff + 4 * t) * PC + C_NK + h * 64 + 8 * g;
                    kfa[(s * 2 + t) * 2] = *(const bf16x8*)kp; kfa[(s * 2 + t) * 2 + 1] = *(const bf16x8*)(kp + 32); } }
        asm volatile("" ::: "memory");
        if (!isctx) asm volatile("" : "+v"(va[0]), "+v"(va[1]), "+v"(va[2]), "+v"(va[3]), "+v"(vb[0]), "+v"(vb[1]), "+v"(vb[2]), "+v"(vb[3]) :: "memory");
        asm volatile("" : "+v"(va[4]), "+v"(va[5]), "+v"(vb[4]), "+v"(vb[5]) :: "memory");
#pragma unroll
        for (int u = 0; u < 6; ++u) { const int it = F.tid + 512 * u, c = it & 7, kp = it >> 3;
            if (isctx && u < 4) continue;
            const u32x4 v0 = va[u], v1 = vb[u];
            LAS unsigned* dst = VT32 + (8 * c) * (VP / 2) + (kp ^ (8 * (c >> 1)));
            dst[0 * (VP / 2)] = (v0.x & 0xffffu) | (v1.x << 16); dst[1 * (VP / 2)] = (v0.x >> 16) | (v1.x & 0xffff0000u);
            dst[2 * (VP / 2)] = (v0.y & 0xffffu) | (v1.y << 16); dst[3 * (VP / 2)] = (v0.y >> 16) | (v1.y & 0xffff0000u);
            dst[4 * (VP / 2)] = (v0.z & 0xffffu) | (v1.z << 16); dst[5 * (VP / 2)] = (v0.z >> 16) | (v1.z & 0xffff0000u);
            dst[6 * (VP / 2)] = (v0.w & 0xffffu) | (v1.w << 16); dst[7 * (VP / 2)] = (v0.w >> 16) | (v1.w & 0xffff0000u); }
        pin4(kc);
#pragma unroll
        for (int u = 0; u < 4; ++u) { const int idx = F.tid + 512 * u, key = idx >> 3, c = idx & 7; *(LAS u32x4*)(KC + key * KP + 8 * c) = kc[u]; }
        if (!isctx && F.tid < 15 * 31) rp[F.tid] = rpv * 1.4426950408889634f;
        if (active && half == 0) {
#pragma unroll
            for (int s = 4; s < 8; ++s)
#pragma unroll
                for (int t = 0; t < 2; ++t) { const bf16_t* kp = P + (size_t)(b * SEQ + (r0 + s) * 64 + band0 + koff + 4 * t) * PC + C_NK + h * 64 + 8 * g;
                    kfb[((s - 4) * 2 + t) * 2] = *(const bf16x8*)kp; kfb[((s - 4) * 2 + t) * 2 + 1] = *(const bf16x8*)(kp + 32); } }
        asm volatile("" ::: "memory"); }
    __syncthreads();
    f32x4 S[8][2];
    float mx = -1e30f, sum = 0.f;
    f32x4 O[4];
#pragma unroll
    for (int dt = 0; dt < 4; ++dt) O[dt] = (f32x4){0.f, 0.f, 0.f, 0.f};
    if (active) {
        if (half == 1) {
#pragma unroll
            for (int s = 0; s < 8; ++s)
#pragma unroll
                for (int t = 0; t < 2; ++t) { const LAS bf16_t* kp = KC + (32 * s + koff + 4 * t) * KP + 8 * g; const bf16x8 f0 = *(const LAS bf16x8*)kp, f1 = *(const LAS bf16x8*)(kp + 32);
                    f32x4 acc = (f32x4){0.f, 0.f, 0.f, 0.f};
                    acc = __builtin_amdgcn_mfma_f32_16x16x32_bf16(f0, q0, acc, 0, 0, 0);
                    acc = __builtin_amdgcn_mfma_f32_16x16x32_bf16(f1, q1, acc, 0, 0, 0);
                    S[s][t] = acc; }
        } else {
            asm volatile("" : "+v"(kfa[0]), "+v"(kfa[1]), "+v"(kfa[2]), "+v"(kfa[3]), "+v"(kfa[4]), "+v"(kfa[5]), "+v"(kfa[6]), "+v"(kfa[7]),
                              "+v"(kfa[8]), "+v"(kfa[9]), "+v"(kfa[10]), "+v"(kfa[11]), "+v"(kfa[12]), "+v"(kfa[13]), "+v"(kfa[14]), "+v"(kfa[15]) :: "memory");
#pragma unroll
            for (int s = 0; s < 4; ++s)
#pragma unroll
                for (int t = 0; t < 2; ++t) { f32x4 acc = (f32x4){0.f, 0.f, 0.f, 0.f};
                    acc = __builtin_amdgcn_mfma_f32_16x16x32_bf16(kfa[(s * 2 + t) * 2], q0, acc, 0, 0, 0);
                    acc = __builtin_amdgcn_mfma_f32_16x16x32_bf16(kfa[(s * 2 + t) * 2 + 1], q1, acc, 0, 0, 0);
                    S[s][t] = acc; }
            asm volatile("" : "+v"(kfb[0]), "+v"(kfb[1]), "+v"(kfb[2]), "+v"(kfb[3]), "+v"(kfb[4]), "+v"(kfb[5]), "+v"(kfb[6]), "+v"(kfb[7]),
                              "+v"(kfb[8]), "+v"(kfb[9]), "+v"(kfb[10]), "+v"(kfb[11]), "+v"(kfb[12]), "+v"(kfb[13]), "+v"(kfb[14]), "+v"(kfb[15]) :: "memory");
#pragma unroll
            for (int s = 4; s < 8; ++s)
#pragma unroll
                for (int t = 0; t < 2; ++t) { f32x4 acc = (f32x4){0.f, 0.f, 0.f, 0.f};
                    acc = __builtin_amdgcn_mfma_f32_16x16x32_bf16(kfb[((s - 4) * 2 + t) * 2], q0, acc, 0, 0, 0);
                    acc = __builtin_amdgcn_mfma_f32_16x16x32_bf16(kfb[((s - 4) * 2 + t) * 2 + 1], q1, acc, 0, 0, 0);
                    S[s][t] = acc; }
        }
        if (half == 0) {
#pragma unroll
            for (int s2 = 0; s2 < 8; s2 += 2) { float bz[16];
#pragma unroll
                for (int u = 0; u < 16; ++u) { const int s = s2 + (u >> 3), kcol = band0 + 8 * g + (u & 7);
                    int dc = kcol - qcol + 15; dc = dc < 0 ? 0 : (dc > 30 ? 30 : dc);
                    bz[u] = rp[(r0 + s - r + 7) * 31 + dc]; }
                pin16(bz);
#pragma unroll
                for (int u = 0; u < 16; ++u) { const int s = s2 + (u >> 3), t = (u >> 2) & 1, j = u & 3, kcol = band0 + 8 * g + (u & 7); const bool valid = kcol >= c0q && kcol < c0q + 16;
                    const float v = valid ? __builtin_fmaf(S[s][t][j], 0.125f * 1.4426950408889634f, bz[u]) : -1e30f;
                    S[s][t][j] = v; mx = fmaxf(mx, v); } }
        } else {
#pragma unroll
            for (int s = 0; s < 8; ++s)
#pragma unroll
                for (int t = 0; t < 2; ++t)
#pragma unroll
                    for (int j = 0; j < 4; ++j) { const float v = S[s][t][j] * (0.125f * 1.4426950408889634f); S[s][t][j] = v; mx = fmaxf(mx, v); }
        }
        mx = fmaxf(mx, __shfl_xor(mx, 16)); mx = fmaxf(mx, __shfl_xor(mx, 32));
#pragma unroll
        for (int s = 0; s < 8; ++s)
#pragma unroll
            for (int t = 0; t < 2; ++t)
#pragma unroll
                for (int j = 0; j < 4; ++j) { const float p = __builtin_amdgcn_exp2f(S[s][t][j] - mx); S[s][t][j] = p; sum += p; }
        sum += __shfl_xor(sum, 16); sum += __shfl_xor(sum, 32);
        const LAS bf16_t* VT = (const LAS bf16_t*)F.lds;
#pragma unroll
        for (int s = 0; s < 8; ++s) {
            u32x4 pw; pw.x = pg8::cvt_pk_bf16(S[s][0][0], S[s][0][1]); pw.y = pg8::cvt_pk_bf16(S[s][0][2], S[s][0][3]);
            pw.z = pg8::cvt_pk_bf16(S[s][1][0], S[s][1][1]); pw.w = pg8::cvt_pk_bf16(S[s][1][2], S[s][1][3]);
            const bf16x8 pf = __builtin_bit_cast(bf16x8, pw);
            const int kbase = (half == 0 ? s * 64 + band0 : 512 + 32 * s) + 8 * g;
#pragma unroll
            for (int dt = 0; dt < 4; ++dt) { const bf16x8 vf = *(const LAS bf16x8*)(VT + (16 * dt + fr) * VP + (kbase ^ (16 * dt)));
                O[dt] = __builtin_amdgcn_mfma_f32_16x16x32_bf16(vf, pf, O[dt], 0, 0, 0); } }
    }
    LAS float* mrow = mg + ((size_t)(n * 64 + F.lane)) * 18;
    if (half == 1) { mrow[0] = mx; mrow[1] = sum;
#pragma unroll
        for (int dt = 0; dt < 4; ++dt)
#pragma unroll
            for (int j = 0; j < 4; ++j) mrow[2 + dt * 4 + j] = O[dt][j]; }
    __syncthreads();
    if (half == 0) {
        const float m1 = mrow[0], s1 = mrow[1];
        const float M = fmaxf(mx, m1), a0 = __builtin_amdgcn_exp2f(mx - M), a1 = __builtin_amdgcn_exp2f(m1 - M);
        const float inv = 1.0f / (sum * a0 + s1 * a1);
        bf16_t* mo = (bf16_t*)(F.ws + WS_MIX) + (size_t)(qrow0 + 16 * n + fr) * D + 768 + h * 64 + 4 * g;
#pragma unroll
        for (int dt = 0; dt < 4; ++dt) { float o[4];
#pragma unroll
            for (int j = 0; j < 4; ++j) o[j] = (O[dt][j] * a0 + mrow[2 + dt * 4 + j] * a1) * inv;
            u32x2 w; w.x = pk2(o[0], o[1]); w.y = pk2(o[2], o[3]);
            *(u32x2*)(mo + 16 * dt) = w; }
    }
    __syncthreads();
}

__device__ __forceinline__ void p5_norm2_router(Frame& F, const Args& A, int l, bool need_ctx) {
    LAS float* wrt = (LAS float*)F.lds;
    LAS float* sc = wrt + 16 * D;
    LAS float* sh = sc + 3 * D;
    LAS float* ng = sh + 3 * D;
    const float* mod = (const float*)(F.ws + WS_MOD) + (size_t)l * 3 * 6144;
    { const float* wsrc = INP(I_WROUT) + (size_t)l * D * 16;
        f32x4 t[8], m[4]; f32x4 gq = (f32x4){0.f, 0.f, 0.f, 0.f};
#pragma unroll
        for (int u = 0; u < 8; ++u) t[u] = *(const f32x4*)(wsrc + 4 * (F.tid + 512 * u));
#pragma unroll
        for (int u = 0; u < 2; ++u) { const int i4 = F.tid + 512 * u, i = 4 * i4, s = i >> 10, j = i & 1023; m[2 * u] = (f32x4){0.f, 0.f, 0.f, 0.f}; m[2 * u + 1] = m[2 * u];
            if (i4 < 768) { m[2 * u] = *(const f32x4*)(mod + s * 6144 + 3072 + j); m[2 * u + 1] = *(const f32x4*)(mod + s * 6144 + 4096 + j); } }
        if (F.tid < 256) gq = *(const f32x4*)(INP(I_N2G) + l * D + 4 * F.tid);
        pin8(t); pin4(m); pin1(gq);
#pragma unroll
        for (int u = 0; u < 8; ++u) { const int i = 4 * (F.tid + 512 * u), c = i >> 4, e = i & 15;
#pragma unroll
            for (int k = 0; k < 4; ++k) wrt[(e + k) * D + c] = t[u][k]; }
#pragma unroll
        for (int u = 0; u < 2; ++u) { const int i4 = F.tid + 512 * u, i = 4 * i4;
            if (i4 < 768) { *(LAS f32x4*)(sh + i) = m[2 * u]; *(LAS f32x4*)(sc + i) = m[2 * u + 1] + 1.0f; } }
        if (F.tid < 256) *(LAS f32x4*)(ng + 4 * F.tid) = gq; }
    __syncthreads();
    const bf16_t* X = (const bf16_t*)(F.ws + WS_X); bf16_t* H = (bf16_t*)(F.ws + WS_H); float* AFF = (float*)(F.ws + WS_AFF);
    const int nrows = need_ctx ? MROWS : NLAT;
    static_assert(CB_P5 >= CV_IN + CV_OUT && CB_DRAIN <= CV_PER_L, "ride-along conversion range");
    const bool cvt_on = need_ctx && F.G == 256;
    LAS float* cscr = (LAS float*)(F.lds + (16 * D + 7 * D) * 4) + F.wave * (64 * 33);
    int krow = 0;
    u32x2 pv[4];
#pragma unroll
    for (int j = 0; j < 4; ++j) pv[j] = (u32x2){0u, 0u};
    if (F.gw < nrows) {
#pragma unroll
        for (int j = 0; j < 4; ++j) pv[j] = *(const u32x2*)(X + (size_t)F.gw * D + 4 * F.lane + 256 * j); }
    for (int row = F.gw; row < nrows; row += F.NGW, ++krow) {
        const int set = row_set(row), ms = set < 2 ? set : 2, tok = row - set_base(set);
        const bool docv = cvt_on && krow < CQ5;
        CvtDesc cd; f32x4 cv[8];
        if (docv) { cd = cvt_decode_moe(F, A, l + 1, CB_P5 + krow * F.NGW + F.gw);
#pragma unroll
            for (int i = 0; i < 8; ++i) { const int kk = 8 * i + (F.lane >> 3), nn = (F.lane & 7) * 4; cv[i] = __builtin_nontemporal_load((const f32x4*)(cd.W + (size_t)(cd.k0 + kk) * cd.N + cd.n0 + nn)); }
            asm volatile("" ::: "memory"); }
        f32x4 v[4]; float ss = 0.f;
#pragma unroll
        for (int j = 0; j < 4; ++j) { v[j] = (f32x4){__uint_as_float(pv[j].x << 16), __uint_as_float(pv[j].x & 0xffff0000u), __uint_as_float(pv[j].y << 16), __uint_as_float(pv[j].y & 0xffff0000u)}; ss += (v[j][0] * v[j][0] + v[j][1] * v[j][1]) + (v[j][2] * v[j][2] + v[j][3] * v[j][3]); }
        if (row + F.NGW < nrows) {
#pragma unroll
            for (int j = 0; j < 4; ++j) pv[j] = *(const u32x2*)(X + (size_t)(row + F.NGW) * D + 4 * F.lane + 256 * j); }
        const float rstd = 1.0f / sqrtf(wave_sum(ss) * (1.0f / D) + EPS);
#pragma unroll
        for (int j = 0; j < 4; ++j) { const int c0 = 4 * F.lane + 256 * j;
            const f32x4 gn = *(const LAS f32x4*)(ng + c0), s1 = *(const LAS f32x4*)(sc + ms * D + c0), h1 = *(const LAS f32x4*)(sh + ms * D + c0);
            v[j] = v[j] * rstd * gn * s1 + h1;
            u32x2 w; w.x = pg8::cvt_pk_bf16(v[j][0], v[j][1]); w.y = pg8::cvt_pk_bf16(v[j][2], v[j][3]);
            *(u32x2*)(H + (size_t)row * D + c0) = w; }
        float mine = 0.f;
#pragma unroll
        for (int e4 = 0; e4 < 16; e4 += 4) {
            f32x4 wq[16];
#pragma unroll
            for (int u = 0; u < 16; ++u) wq[u] = *(const LAS f32x4*)(wrt + (e4 + (u >> 2)) * D + 4 * F.lane + 256 * (u & 3));
            pin16(wq);
#pragma unroll
            for (int ee = 0; ee < 4; ++ee) { float a = 0.f;
#pragma unroll
                for (int j = 0; j < 4; ++j) { const f32x4 w = wq[ee * 4 + j]; a += v[j][0] * w[0] + v[j][1] * w[1] + v[j][2] * w[2] + v[j][3] * w[3]; }
                a += __int_as_float(__builtin_amdgcn_update_dpp(0, __float_as_int(a), 0xB1, 0xf, 0xf, true));
                a += __int_as_float(__builtin_amdgcn_update_dpp(0, __float_as_int(a), 0x4E, 0xf, 0xf, true));
                a += __int_as_float(__builtin_amdgcn_update_dpp(0, __float_as_int(a), 0x124, 0xf, 0xf, true));
                a += __int_as_float(__builtin_amdgcn_update_dpp(0, __float_as_int(a), 0x128, 0xf, 0xf, true));
                mine = ((F.lane & 15) == e4 + ee) ? a : mine; } }
        mine += __shfl_xor(mine, 16); mine += __shfl_xor(mine, 32);
        float mx = mine;
        mx = fmaxf(mx, __int_as_float(__builtin_amdgcn_update_dpp(0, __float_as_int(mx), 0xB1, 0xf, 0xf, true)));
        mx = fmaxf(mx, __int_as_float(__builtin_amdgcn_update_dpp(0, __float_as_int(mx), 0x4E, 0xf, 0xf, true)));
        mx = fmaxf(mx, __int_as_float(__builtin_amdgcn_update_dpp(0, __float_as_int(mx), 0x124, 0xf, 0xf, true)));
        mx = fmaxf(mx, __int_as_float(__builtin_amdgcn_update_dpp(0, __float_as_int(mx), 0x128, 0xf, 0xf, true)));
        const float pe = expf(mine - mx);
        float sum = pe;
        sum += __int_as_float(__builtin_amdgcn_update_dpp(0, __float_as_int(sum), 0xB1, 0xf, 0xf, true));
        sum += __int_as_float(__builtin_amdgcn_update_dpp(0, __float_as_int(sum), 0x4E, 0xf, 0xf, true));
        sum += __int_as_float(__builtin_amdgcn_update_dpp(0, __float_as_int(sum), 0x124, 0xf, 0xf, true));
        sum += __int_as_float(__builtin_amdgcn_update_dpp(0, __float_as_int(sum), 0x128, 0xf, 0xf, true));
        if (F.lane < 16) { const float p = pe / sum;
            if (set < 2) AFF[((size_t)set * NE + F.lane) * SEQ + tok] = p; else AFF[(size_t)2 * NE * SEQ + ((size_t)(set - 2) * NE + F.lane) * CTX + tok] = p; }
        if (docv) {
#pragma unroll
            for (int i = 0; i < 8; ++i) { const int kk = 8 * i + (F.lane >> 3), nn = (F.lane & 7) * 4; LAS float* sp = cscr + kk * 33 + nn; sp[0] = cv[i][0]; sp[1] = cv[i][1]; sp[2] = cv[i][2]; sp[3] = cv[i][3]; }
            LDS_WAIT();
            const int c = F.lane & 7;
#pragma unroll
            for (int j = 0; j < 4; ++j) { const int n = (F.lane >> 3) + 8 * j; const LAS float* sp = cscr + (8 * c) * 33 + n;
                u32x4 o; o.x = pk2(sp[0 * 33], sp[1 * 33]); o.y = pk2(sp[2 * 33], sp[3 * 33]); o.z = pk2(sp[4 * 33], sp[5 * 33]); o.w = pk2(sp[6 * 33], sp[7 * 33]);
                *(u32x4*)(cd.WT + (cd.dr + n) * (size_t)cd.K + cd.k0 + 8 * c) = o; }
            LDS_WAIT(); }
    }
}

template <int N, int TPT, int CAP>
__device__ __forceinline__ void select_set(Frame& F, const float* aff, int* slot_out, int xs_row0, int h_row0, int part, int nparts) {
    LAS unsigned* keys = (LAS unsigned*)F.lds;
    LAS unsigned* hist = keys + N;
    LAS unsigned* ctl = hist + 256;
    LAS unsigned* wtot = ctl + 8;
    LAS int* glist = (LAS int*)(wtot + 16);
    { constexpr int NL = N / 512 > 0 ? N / 512 : 1; float av[NL];
#pragma unroll
        for (int u = 0; u < NL; ++u) av[u] = (F.tid + 512 * u < N) ? aff[F.tid + 512 * u] : 0.f;
#pragma unroll
        for (int u = 0; u < NL; ++u) if (F.tid + 512 * u < N) keys[F.tid + 512 * u] = __float_as_uint(av[u]); }
    __syncthreads();
    unsigned kreg[TPT];
#pragma unroll
    for (int u = 0; u < TPT; ++u) kreg[u] = F.tid * TPT < N ? keys[F.tid * TPT + u] : 0u;
    LAS unsigned* cnt = hist;
    unsigned T = 0u;
    for (int bit = 29; bit >= 0; --bit) {
        const unsigned cand = T | (1u << bit);
        unsigned c = 0;
#pragma unroll
        for (int u = 0; u < TPT; ++u) c += (unsigned)__builtin_popcountll(__ballot(kreg[u] >= cand));
        LAS unsigned* cb = cnt + (bit & 1) * 8;
        if (F.lane == 0) cb[F.wave] = c;
        __syncthreads();
        unsigned tot = 0;
#pragma unroll
        for (int w = 0; w < 8; ++w) tot += cb[w];
        if (tot >= (unsigned)CAP) T = cand;
    }
    unsigned need_eq;
    { unsigned c = 0;
#pragma unroll
        for (int u = 0; u < TPT; ++u) c += (unsigned)__builtin_popcountll(__ballot(kreg[u] > T));
        __syncthreads();
        if (F.lane == 0) cnt[F.wave] = c;
        __syncthreads();
        unsigned tot = 0;
#pragma unroll
        for (int w = 0; w < 8; ++w) tot += cnt[w];
        need_eq = (unsigned)CAP - tot; }
    __syncthreads();
    unsigned cg = 0, ce = 0;
    if (F.tid * TPT < N) {
#pragma unroll
        for (int u = 0; u < TPT; ++u) { const unsigned k = keys[F.tid * TPT + u]; cg += k > T; ce += k == T; } }
    unsigned pk = cg | (ce << 16), inc = pk;
#pragma unroll
    for (int o = 1; o < 64; o <<= 1) { const unsigned t = __shfl_up(inc, o); if (F.lane >= o) inc += t; }
    if (F.lane == 63) wtot[F.wave] = inc;
    __syncthreads();
    unsigned base = 0;
    for (int w = 0; w < F.wave; ++w) base += wtot[w];
    unsigned exc = base + inc - pk;
    unsigned g_before = exc & 0xffffu, e_before = exc >> 16;
    const int per = N / nparts, lo = part * per, hi = lo + per;
    if (F.tid * TPT == lo) ctl[2] = g_before + (e_before < need_eq ? e_before : need_eq);
    __syncthreads();
    const unsigned part_first = ctl[2];
    if (F.tid * TPT < N && F.tid * TPT >= lo && F.tid * TPT < hi) {
#pragma unroll
        for (int u = 0; u < TPT; ++u) { const int tok = F.tid * TPT + u; const unsigned k = keys[tok];
            int sl = -1;
            if (k > T) { sl = (int)(g_before + (e_before < need_eq ? e_before : need_eq)); ++g_before; }
            else if (k == T) { if (e_before < need_eq) sl = (int)(g_before + e_before); ++e_before; }
            slot_out[tok] = sl;
            if (sl >= 0) { ((int*)(F.ws + WS_XS))[xs_row0 + sl] = h_row0 + tok; ((float*)(F.ws + WS_GSEL))[xs_row0 + sl] = __uint_as_float(k); } }
    }
    __syncthreads();
}
__device__ __forceinline__ void p6_select(Frame& F, bool need_ctx) {
    const float* AFF = (const float*)(F.ws + WS_AFF); int* SLOT = (int*)(F.ws + WS_SLOT);
    const int ntask = 256 + (need_ctx ? 32 : 0);
    for (int task = F.vcu; task < ntask; task += F.G) {
        if (task < 256) { const int set = task >> 3, part = task & 7, b = set >> 4, e = set & 15;
            select_set<SEQ, 16, 1024>(F, AFF + (size_t)set * SEQ, SLOT + (size_t)set * SEQ, e * XS_PER_E + b * 1024, b * SEQ, part, 8);
            (void)b; }
        else { const int set = task - 256, b = set >> 4, e = set & 15;
            select_set<CTX, 1, 32>(F, AFF + (size_t)2 * NE * SEQ + (size_t)set * CTX, SLOT + (size_t)2 * NE * SEQ + (size_t)set * CTX, e * XS_PER_E + 2048 + b * 32, NLAT + b * CTX, 0, 1); }
        __syncthreads();
    }
}

constexpr int PH_PER_L = 10, PH_FINAL = 1 + DEPTH * PH_PER_L, PH_COUNT = PH_FINAL + 1;

__global__ void __launch_bounds__(NWAVES * 64, 2) dit_fwd(Args args) {
    extern __shared__ __attribute__((aligned(16))) unsigned char lds_raw[];
    Frame F0;
    F0.lds = (LAS unsigned char*)lds_raw;
    F0.tid = threadIdx.x; F0.lane = F0.tid & 63; F0.wave = __builtin_amdgcn_readfirstlane(F0.tid >> 6);
    F0.G = gridDim.x; F0.bx = blockIdx.x; { const int bx = blockIdx.x; F0.vcu = (F0.G % 8 == 0) ? (bx % 8) * (F0.G / 8) + bx / 8 : bx; }
    F0.gw = F0.vcu * NWAVES + F0.wave; F0.NGW = F0.G * NWAVES;
    F0.ws = args.ws;
    volatile LAS unsigned* misc = (volatile LAS unsigned*)(F0.lds + LDS_MISC);
    if (F0.tid < 4) misc[F0.tid] = 0u;
    __syncthreads();
#if MK_SINGLE
    XcdBarrier bar = xcd_barrier_post((unsigned*)(F0.ws + WS_CTL) + 4096, misc);
#define GRID_BAR() xcd_barrier(bar)
#else
#define GRID_BAR() do { } while (0)
#endif
    const int lo = args.ph_lo, hi = args.ph_hi;
#ifndef EN_MASK
#define EN_MASK 0xFFFF
#endif
#define EN(q) ((EN_MASK >> (q)) & 1)
#define IN(k) (lo <= (k) && (k) < hi)
#define SEAM(k) do { if (IN((k) + 1)) { GRID_BAR(); if (PROBE_BAR) GRID_BAR(); } } while (0)

    if (EN(0) && IN(0)) { for (int rep = 0; rep < REP_P0; ++rep) { Frame F = launder(F0); p0_prologue(F, args); __syncthreads(); } SEAM(0); }

    for (int l = 0; l < DEPTH; ++l) {
        const int pb = 1 + l * PH_PER_L; const bool need_ctx = l < DEPTH - 1;
        if (EN(1) && IN(pb + 0)) { if (PROBE_DRY) { Frame F = launder(F0); p1_norm1(F, args, l, true); __syncthreads(); } Frame F = launder(F0); p1_norm1(F, args, l); __syncthreads(); SEAM(pb + 0); }
        if (EN(2) && IN(pb + 1)) for (int rep = 0; rep < REP_GEMM; ++rep) { Frame F = launder(F0);
            pg8::Gemm g{(const bf16_t*)(F.ws + WS_H), (const bf16_t*)(F.ws + WS_WIN) + (size_t)l * INC * D, D};
            pg8::StaticOrder S; S.init(MROWS, PC, F.G, F.bx);
            pg8::EpiBf16 E{(bf16_t*)(F.ws + WS_P), PC};
            pg8::gemm_phase(F.lds, F.tid, g, S, E);
            p2_gate_feats(F, l);
            __syncthreads(); SEAM(pb + 1);
        }
        if (EN(3) && IN(pb + 2)) { Frame F = launder(F0);
            for (int rep = 0; rep < REP_MIX; ++rep) {
                if (F.vcu & 1) {
                    for (int t = (F.vcu + F.G - 48) % F.G; t < 1056; t += F.G) { Frame F1 = launder(F); for (int r2 = 0; r2 < REP_GLA; ++r2) t_gla_main(F1, args, l, t, need_ctx); }
                    for (int t = (F.vcu + F.G - 80) % F.G; t < 528; t += F.G) { Frame F1 = launder(F); for (int r2 = 0; r2 < REP_GMLP; ++r2) t_gmlp_mfma(F1, args, l, t, need_ctx); }
                    for (int t = F.vcu; t < 528; t += F.G) { Frame F1 = launder(F); for (int r2 = 0; r2 < REP_LRU; ++r2) t_lru_half(F1, args, l, t); }
                    for (int t = (F.vcu + F.G - 16) % F.G; t < 1056; t += F.G) { Frame F1 = launder(F); for (int r2 = 0; r2 < REP_NAT; ++r2) t_nat_mfma(F1, args, l, t, need_ctx); }
                } else {
                    for (int t = F.vcu; t < 528; t += F.G) { Frame F1 = launder(F); for (int r2 = 0; r2 < REP_LRU; ++r2) t_lru_half(F1, args, l, t); }
                    for (int t = (F.vcu + F.G - 16) % F.G; t < 1056; t += F.G) { Frame F1 = launder(F); for (int r2 = 0; r2 < REP_NAT; ++r2) t_nat_mfma(F1, args, l, t, need_ctx); }
                    for (int t = (F.vcu + F.G - 48) % F.G; t < 1056; t += F.G) { Frame F1 = launder(F); for (int r2 = 0; r2 < REP_GLA; ++r2) t_gla_main(F1, args, l, t, need_ctx); }
                    for (int t = (F.vcu + F.G - 80) % F.G; t < 528; t += F.G) { Frame F1 = launder(F); for (int r2 = 0; r2 < REP_GMLP; ++r2) t_gmlp_mfma(F1, args, l, t, need_ctx); }
                }
            }
            __syncthreads(); SEAM(pb + 2);
        }
        if (EN(4) && IN(pb + 3)) { Frame F = launder(F0);
            if (PROBE_DRY) { for (int t = F.vcu; t < 130; t += F.G) { if (t < 128) t_gla_scan(F, t, true); else t_lru_scan(F, t - 128, true); } }
            for (int t = F.vcu; t < 130; t += F.G) { if (t < 128) t_gla_scan(F, t); else t_lru_scan(F, t - 128); }
            if (need_ctx && F.G == 256 && F.vcu >= 130) cvt_range(F, args, l + 1, CB3 + (F.vcu - 130) * CQ3, CQ3);
            __syncthreads(); SEAM(pb + 3);
        }
        if (EN(5) && IN(pb + 4)) { Frame F = launder(F0);
            constexpr int T0 = 2 * NCH * 4, T1 = T0 + 264;
            for (int rep = 0; rep < REP_MIX; ++rep) {
                for (int wt = F.gw; wt < 2 * NCH * 16; wt += F.NGW) for (int r2 = 0; r2 < REP_GLA; ++r2) t_gla_fin_wave(F, args, l, wt, need_ctx);
                for (int t = F.vcu; t < 264; t += F.G) { Frame F1 = launder(F); for (int r2 = 0; r2 < REP_LRU; ++r2) t_lru_fix(F1, t, need_ctx); }
            }
            (void)T0; (void)T1;
            __syncthreads(); SEAM(pb + 4);
        }
        if (EN(6) && IN(pb + 5)) { Frame F = launder(F0);
            pg8::Gemm g{(const bf16_t*)(F.ws + WS_MIX), (const bf16_t*)(F.ws + WS_WOUT) + (size_t)l * D * D, D};
            pg8::StaticOrder S; S.init(need_ctx ? MROWS : NLAT, D, F.G, F.bx);
            pg8::EpiResGate E{(bf16_t*)(F.ws + WS_X), (const float*)(F.ws + WS_MOD) + (size_t)l * 3 * 6144};
            pg8::gemm_phase(F.lds, F.tid, g, S, E);
            if (need_ctx && F.G == 256 && F.bx >= 8) cvt_range(F, args, l + 1, CB4 + (F.bx - 8) * CQ4, CQ4);
            __syncthreads(); SEAM(pb + 5);
        }
        if (EN(7) && IN(pb + 6)) for (int rep = 0; rep < REP_SMALL * REP_P5; ++rep) { Frame F = launder(F0); p5_norm2_router(F, args, l, need_ctx); __syncthreads(); SEAM(pb + 6); }
        if (EN(8) && IN(pb + 7)) for (int rep = 0; rep < REP_SMALL; ++rep) { Frame F = launder(F0); p6_select(F, need_ctx); __syncthreads(); SEAM(pb + 7); }
        if (EN(9) && IN(pb + 8)) for (int rep = 0; rep < REP_GEMM; ++rep) { Frame F = launder(F0);
            pg8::Gemm g{(const bf16_t*)(F.ws + WS_H), (const bf16_t*)(F.ws + WS_W1) + (size_t)l * NE * 4096 * D, D};
            pg8::MoeOrder S; S.init(need_ctx ? 9 : 8, 16, F.G, F.vcu);
            pg8::EpiSwiglu E{(bf16_t*)(F.ws + WS_HID), FF};
            LAS int* idxl = (LAS int*)(F.lds + pg8::STAGE_BYTES);
            { const int* IDX = (const int*)(F.ws + WS_XS); pg8::Unit u;
                for (int i = 0; i < 31 && S.next(i, u); ++i) if (F.tid < 256)   { const bool pad = (u.pm % 9 == 8) && F.tid >= 64; idxl[i * 256 + F.tid] = pad ? 0 : IDX[u.pm * 256 + F.tid]; } }
            __syncthreads();
            pg8::gemm_phase_gather(F.lds, F.tid, g, S, E, idxl);
            __syncthreads(); SEAM(pb + 8);
        }
        if (EN(10) && IN(pb + 9)) for (int rep = 0; rep < REP_GEMM; ++rep) { Frame F = launder(F0);
            pg8::Gemm g{(const bf16_t*)(F.ws + WS_HID), (const bf16_t*)(F.ws + WS_W2) + (size_t)l * NE * D * FF, FF};
            pg8::MoeOrder2K S; S.init(need_ctx, F.G, F.vcu);
            pg8::EpiBf16 E{(bf16_t*)(F.ws + WS_Y), D, (bf16_t*)(F.ws + WS_Y2)};
            pg8::gemm_phase(F.lds, F.tid, g, S, E);
            if (need_ctx && F.G == 256) { if (F.vcu >= 128) cvt_range_moe4(F, args, l + 1, CB8 + (F.vcu - 128) * CQ8, CQ8); else cvt_range_moe4(F, args, l + 1, CB8 + 128 * CQ8 + F.vcu * CQ8B, CQ8B); }
            __syncthreads(); SEAM(pb + 9);
        }
    }
    if (EN(1) && IN(PH_FINAL)) { if (PROBE_DRY) { Frame F = launder(F0); p1_norm1(F, args, DEPTH, true); __syncthreads(); } Frame F = launder(F0); p1_norm1(F, args, DEPTH); }
#undef IN
#undef SEAM
}

extern "C" void kernel_launch(void* const* d_in, const int* in_sizes, int n_in, void* d_out, int out_size, void* d_ws, size_t ws_size, hipStream_t stream) {
    static int grid = 0;
    if (grid == 0) {
        if (n_in != 29 || ws_size < WS_END) { fprintf(stderr, "kernel_launch: need 29 inputs and %zu bytes of workspace; got %d inputs, %zu bytes\n", (size_t)WS_END, n_in, ws_size); grid = -1; return; }
        int dev = 0, cus = 0, per_cu = 0;
        if (hipGetDevice(&dev) != hipSuccess || hipDeviceGetAttribute(&cus, hipDeviceAttributeMultiprocessorCount, dev) != hipSuccess) { grid = -1; return; }
        if (hipFuncSetAttribute((const void*)dit_fwd, hipFuncAttributeMaxDynamicSharedMemorySize, LDS_BYTES) != hipSuccess) { fprintf(stderr, "kernel_launch: hipFuncSetAttribute failed\n"); grid = -1; return; }
        if (hipOccupancyMaxActiveBlocksPerMultiprocessor(&per_cu, (const void*)dit_fwd, NWAVES * 64, LDS_BYTES) != hipSuccess || per_cu < 1) { fprintf(stderr, "kernel_launch: occupancy query says %d\n", per_cu); grid = -1; return; }
        (void)hipGetLastError();
        grid = cus;
    }
    if (grid < 0) return;
    (void)in_sizes; (void)out_size;
    (void)hipMemsetAsync((char*)d_ws + WS_CTL, 0, CTL_BYTES, stream);
    Args a{};
    for (int i = 0; i < 29; ++i) a.in[i] = (const float*)d_in[i];
    a.out = (float*)d_out; a.ws = (unsigned char*)d_ws;
#if MK_SINGLE
    a.ph_lo = 0; a.ph_hi = PH_COUNT;
    hipLaunchKernelGGL(dit_fwd, dim3(grid), dim3(NWAVES * 64), LDS_BYTES, stream, a);
#else
    for (int p = 0; p < PH_COUNT; ++p) { a.ph_lo = p; a.ph_hi = p + 1; hipLaunchKernelGGL(dit_fwd, dim3(grid), dim3(NWAVES * 64), LDS_BYTES, stream, a); }
#endif
}
```

```cpp
#include <hip/hip_runtime.h>
#include <cstdio>
#include <cstdint>

#define LAS __attribute__((address_space(3)))
#define GAS __attribute__((address_space(1)))
typedef unsigned short bf16_t;
typedef short bf16x8 __attribute__((ext_vector_type(8)));
typedef float f32x4 __attribute__((ext_vector_type(4)));
typedef float f32x2 __attribute__((ext_vector_type(2)));
typedef unsigned u32x4 __attribute__((ext_vector_type(4)));
typedef unsigned u32x2 __attribute__((ext_vector_type(2)));

#ifndef REP_P0
#define REP_P0 1
#endif
#ifndef REP_MIX
#define REP_MIX 1
#endif
#ifndef REP_GLA
#define REP_GLA 1
#endif
#ifndef REP_NAT
#define REP_NAT 1
#endif
#ifndef PROBE_DRY
#define PROBE_DRY 0
#endif
#ifndef PROBE_BAR
#define PROBE_BAR 0
#endif
#ifndef REP_LRU
#define REP_LRU 1
#endif
#ifndef REP_GMLP
#define REP_GMLP 1
#endif
#ifndef REP_P5
#define REP_P5 1
#endif
#ifndef REP_SMALL
#define REP_SMALL 1
#endif
#ifndef REP_GEMM
#define REP_GEMM 1
#endif
#ifndef MK_SINGLE
#define MK_SINGLE 1
#endif

constexpr int D = 1024, NB = 2, SEQ = 8192, CTX = 256, DEPTH = 4;
constexpr int NLAT = NB * SEQ, NCTXR = NB * CTX, MROWS = NLAT + NCTXR;
constexpr int INC = 2848, PC = 2816;
constexpr int C_Q = 0, C_K = 256, C_V = 512, C_OG = 768, C_GU = 1024, C_GV = 1280, C_LX = 1536, C_LY = 1792, C_NQ = 2048, C_NK = 2304, C_NV = 2560;
constexpr int NE = 16, FF = 2048;
constexpr int XS_PER_E = 2304, XS_ROWS = NE * XS_PER_E;
constexpr int NCH = 132;
constexpr float EPS = 1e-6f;

constexpr size_t MiB = 1u << 20;
constexpr size_t al256(size_t x) { return (x + 255) & ~(size_t)255; }
constexpr size_t WS_CTL = 0, CTL_BYTES = 1 * MiB;
constexpr size_t WS_MODP = WS_CTL + CTL_BYTES;
constexpr size_t WS_MOD = WS_MODP + al256((size_t)DEPTH * 8 * 3 * 6144 * 4);
constexpr size_t WS_WIN = WS_MOD + al256((size_t)DEPTH * 3 * 6144 * 4);
constexpr size_t WS_WOUT = WS_WIN + al256((size_t)DEPTH * INC * D * 2);
constexpr size_t WS_W1 = WS_WOUT + al256((size_t)DEPTH * D * D * 2);
constexpr size_t WS_W2 = WS_W1 + al256((size_t)DEPTH * NE * 4096 * D * 2);
constexpr size_t WS_X = WS_W2 + al256((size_t)DEPTH * NE * D * FF * 2);
constexpr size_t WS_H = WS_X + al256((size_t)MROWS * D * 4);
constexpr size_t WS_P = WS_H + al256((size_t)MROWS * D * 2);
constexpr size_t WS_Z = WS_P + al256((size_t)MROWS * PC * 2);
constexpr size_t WS_MIX = WS_Z + al256((size_t)MROWS * 32 * 4);
constexpr size_t WS_KV = WS_MIX + al256((size_t)MROWS * D * 2);
constexpr size_t WS_DEC = WS_KV + al256((size_t)2 * 2 * 4 * NCH * 4096 * 4);
constexpr size_t WS_LH = WS_DEC + al256((size_t)2 * 2 * 4 * NCH * 64 * 4);
constexpr size_t WS_LA = WS_LH + al256((size_t)2 * MROWS * 256 * 4);
constexpr size_t WS_LSA = WS_LA + al256((size_t)2 * MROWS * 256 * 4);
constexpr size_t WS_LSH = WS_LSA + al256((size_t)2 * 2 * NCH * 256 * 4);
constexpr size_t WS_LC = WS_LSH + al256((size_t)2 * 2 * NCH * 256 * 4);
constexpr size_t WS_AFF = WS_LC + al256((size_t)2 * 2 * NCH * 256 * 4);
constexpr size_t WS_SLOT = WS_AFF + al256((size_t)(2 * 16 * 8192 + 2 * 16 * 256) * 4);
constexpr size_t WS_GSEL = WS_SLOT + al256((size_t)(2 * 16 * 8192 + 2 * 16 * 256) * 4);
constexpr size_t WS_XS = WS_GSEL + al256((size_t)XS_ROWS * 4);
constexpr size_t WS_HID = WS_XS + al256((size_t)XS_ROWS * D * 2);
constexpr size_t WS_Y = WS_HID + al256((size_t)XS_ROWS * FF * 2);
constexpr size_t WS_LRUW = WS_Y + al256((size_t)XS_ROWS * D * 2);
constexpr size_t WS_ROPE = WS_LRUW + al256((size_t)DEPTH * 16 * 4096 * 2);
constexpr size_t WS_OI = WS_ROPE + al256((size_t)128 * 16 * 2 * 4);
constexpr size_t WS_QIG = WS_OI + al256((size_t)2 * NCH * 4 * 4 * 64 * 16 * 4);
constexpr size_t WS_SS = WS_QIG + al256((size_t)2 * NCH * 4 * 2 * 4 * 64 * 16 * 2);
constexpr size_t WS_MWS = WS_SS + al256((size_t)16 * NCH * 4096 * 2);
constexpr size_t WS_END = WS_MWS + al256((size_t)DEPTH * 4 * 128 * 128 * 2);

constexpr int LDS_BYTES = 163840;
constexpr int LDS_MISC = 163840 - 256;
constexpr int NWAVES = 8;

__device__ __forceinline__ float bf2f(unsigned b) { return __uint_as_float(b << 16); }
typedef __bf16 bf16x2_t __attribute__((ext_vector_type(2)));
__device__ __forceinline__ unsigned pk2(float lo, float hi) { const f32x2 v = {lo, hi}; return __builtin_bit_cast(unsigned, __builtin_convertvector(v, bf16x2_t)); }
__device__ __forceinline__ unsigned f2bf(float f) { return pk2(f, 0.f) & 0xffffu; }
__device__ __forceinline__ float wave_sum(float v) {
    v += __int_as_float(__builtin_amdgcn_update_dpp(0, __float_as_int(v), 0xB1, 0xf, 0xf, true));
    v += __int_as_float(__builtin_amdgcn_update_dpp(0, __float_as_int(v), 0x4E, 0xf, 0xf, true));
    v += __int_as_float(__builtin_amdgcn_update_dpp(0, __float_as_int(v), 0x124, 0xf, 0xf, true));
    v += __int_as_float(__builtin_amdgcn_update_dpp(0, __float_as_int(v), 0x128, 0xf, 0xf, true));
    const int iv = __float_as_int(v);
    return (__int_as_float(__builtin_amdgcn_readlane(iv, 0)) + __int_as_float(__builtin_amdgcn_readlane(iv, 16))) + (__int_as_float(__builtin_amdgcn_readlane(iv, 32)) + __int_as_float(__builtin_amdgcn_readlane(iv, 48)));
}
__device__ __forceinline__ float wave_max(float v) {
#pragma unroll
    for (int o = 1; o < 64; o <<= 1) v = fmaxf(v, __shfl_xor(v, o));
    return v;
}
template <class T> __device__ __forceinline__ void pin1(T& a) { asm volatile("" : "+v"(a) :: "memory"); }
template <class T> __device__ __forceinline__ void pin2(T (&x)[2]) { asm volatile("" : "+v"(x[0]), "+v"(x[1]) :: "memory"); }
template <class T> __device__ __forceinline__ void pin4(T (&x)[4]) { asm volatile("" : "+v"(x[0]), "+v"(x[1]), "+v"(x[2]), "+v"(x[3]) :: "memory"); }
template <class T> __device__ __forceinline__ void pin6(T (&x)[6]) { asm volatile("" : "+v"(x[0]), "+v"(x[1]), "+v"(x[2]), "+v"(x[3]), "+v"(x[4]), "+v"(x[5]) :: "memory"); }
template <class T> __device__ __forceinline__ void pin8(T (&x)[8]) { asm volatile("" : "+v"(x[0]), "+v"(x[1]), "+v"(x[2]), "+v"(x[3]), "+v"(x[4]), "+v"(x[5]), "+v"(x[6]), "+v"(x[7]) :: "memory"); }
template <class T> __device__ __forceinline__ void pin12(T (&x)[12]) { asm volatile("" : "+v"(x[0]), "+v"(x[1]), "+v"(x[2]), "+v"(x[3]), "+v"(x[4]), "+v"(x[5]), "+v"(x[6]), "+v"(x[7]), "+v"(x[8]), "+v"(x[9]), "+v"(x[10]), "+v"(x[11]) :: "memory"); }
template <class T> __device__ __forceinline__ void pin16(T (&x)[16]) { asm volatile("" : "+v"(x[0]), "+v"(x[1]), "+v"(x[2]), "+v"(x[3]), "+v"(x[4]), "+v"(x[5]), "+v"(x[6]), "+v"(x[7]),
                                                                                    "+v"(x[8]), "+v"(x[9]), "+v"(x[10]), "+v"(x[11]), "+v"(x[12]), "+v"(x[13]), "+v"(x[14]), "+v"(x[15]) :: "memory"); }
__device__ __forceinline__ float sigmoidf_(float x) { return 1.0f / (1.0f + expf(-x)); }
__device__ __forceinline__ float siluf_(float x) { return x / (1.0f + expf(-x)); }
__device__ __forceinline__ float softplusf_(float x) { return fmaxf(x, 0.f) + log1pf(expf(-fabsf(x))); }
__device__ __forceinline__ float logsigmoidf_(float x) { return -softplusf_(-x); }
__device__ __forceinline__ float gelu_tanh(float x) { const float u = 0.7978845608028654f * (x + 0.044715f * x * x * x); return x * __builtin_amdgcn_rcpf(1.0f + __expf(-2.0f * u)); }
__device__ __forceinline__ float silu_fast(float x) { return x * __builtin_amdgcn_rcpf(1.0f + __expf(-x)); }
__device__ __forceinline__ float ln_1to2(float y) { return __builtin_amdgcn_logf(y) * 0.6931471805599453f; }
__device__ __forceinline__ float logsigmoid_fast(float x) { return (x < 0.f ? x : 0.f) - ln_1to2(1.0f + __builtin_amdgcn_exp2f(-1.4426950408889634f * fabsf(x))); }
#define LDS_WAIT() asm volatile("s_waitcnt lgkmcnt(0)" ::: "memory")
__device__ __forceinline__ float rope_inv(int a) { return powf(10000.0f, -(float)a / 16.0f); }

#define XB_TMO      128
#define XB_XCNT(j)  (256  + 64 * (j))
#define XB_XSUB(j)  (1280 + 64 * (j))
#define XB_XGEN(j)  (2304 + 64 * (j))
#define XB_TOP      3328
#define XB_TOPGEN   3392
#define XCD_BAR_WORDS 3456
#define XB_SPIN_CAP (1u << 18)
__device__ __forceinline__ unsigned xb_ld(unsigned* p)              { return __hip_atomic_load(p, __ATOMIC_RELAXED, __HIP_MEMORY_SCOPE_AGENT); }
__device__ __forceinline__ unsigned xb_add(unsigned* p, unsigned v) { return __hip_atomic_fetch_add(p, v, __ATOMIC_RELAXED, __HIP_MEMORY_SCOPE_AGENT); }
__device__ __forceinline__ unsigned xb_xcc_id() { return (unsigned)__builtin_amdgcn_s_getreg((3 << 11) | 20) & 0xFu; }
#define XB_SPIN(cond, bar) do { unsigned _sp = 0; while (cond) { __builtin_amdgcn_s_sleep(1); \
    if ((++_sp & 255u) == 0u) { if (xb_ld(&(bar)[XB_TMO])) break; if (_sp > XB_SPIN_CAP) { atomicAdd(&(bar)[XB_TMO], 1u); break; } } } } while (0)
struct XcdBarrier { unsigned* bar; unsigned x; volatile LAS unsigned* st; };
__device__ __forceinline__ XcdBarrier xcd_barrier_post(unsigned* bar, volatile LAS unsigned* st) {
    XcdBarrier b; b.bar = bar; b.x = xb_xcc_id(); b.st = st;
    if (threadIdx.x == 0) (void)xb_add(&bar[XB_XCNT(b.x)], 1u);
    return b;
}
__device__ __forceinline__ void xcd_barrier_complete(unsigned* bar, unsigned x, unsigned& nloc, unsigned& nx) {
    const unsigned G = gridDim.x * gridDim.y * gridDim.z;
    unsigned sum, cnt, mine, sp = 0u;
    for (;;) {
        sum = 0u; cnt = 0u; mine = 0u;
#pragma unroll
        for (unsigned j = 0; j < 16; ++j) { const unsigned c = xb_ld(&bar[XB_XCNT(j)]); sum += c; cnt += (c > 0u) ? 1u : 0u; mine = (j == x) ? c : mine; }
        if (sum == G) break;
        __builtin_amdgcn_s_sleep(1);
        if ((++sp & 255u) == 0u) { if (xb_ld(&bar[XB_TMO])) break; if (sp > XB_SPIN_CAP) { atomicAdd(&bar[XB_TMO], 1u); break; } }
    }
    nloc = mine > 0u ? mine : 1u; nx = cnt > 0u ? cnt : 1u;
}
__device__ __forceinline__ void xcd_barrier(const XcdBarrier& b) {
    asm volatile("s_waitcnt vmcnt(0)" ::: "memory");
    __syncthreads();
    if (threadIdx.x == 0) {
        unsigned* bar = b.bar;
        __builtin_amdgcn_s_waitcnt(0);
        unsigned nloc = b.st[0], nx = b.st[1];
        if (nloc == 0u) { xcd_barrier_complete(bar, b.x, nloc, nx); b.st[0] = nloc; b.st[1] = nx; }
        const unsigned old = xb_add(&bar[XB_XSUB(b.x)], 1u);
        const unsigned gen = old / nloc;
        if (old + 1u == (gen + 1u) * nloc) {
            __builtin_amdgcn_fence(__ATOMIC_RELEASE, "agent");
            asm volatile("s_waitcnt vmcnt(0)" ::: "memory");
            const unsigned og = xb_add(&bar[XB_TOP], 1u);
            const unsigned tg = og / nx;
            if (og + 1u == (tg + 1u) * nx) xb_add(&bar[XB_TOPGEN], 1u);
            else XB_SPIN(xb_ld(&bar[XB_TOPGEN]) == tg, bar);
            __builtin_amdgcn_fence(__ATOMIC_ACQUIRE, "agent");
            xb_add(&bar[XB_XGEN(b.x)], 1u);
            asm volatile("s_waitcnt vmcnt(0)" ::: "memory");
        } else {
            XB_SPIN(xb_ld(&bar[XB_XGEN(b.x)]) == gen, bar);
            __builtin_amdgcn_fence(__ATOMIC_ACQUIRE, "agent");
            asm volatile("s_waitcnt vmcnt(0)" ::: "memory");
        }
    }
    __syncthreads();
}

namespace pg8 {
constexpr int BM = 256, BK = 64, HALF = 128, HTB = HALF * BK * 2, STAGE_BYTES = 8 * HTB, NXCD = 8, WGM = 8;
__host__ __device__ __forceinline__ int lds_byte(int r, int c) { const int st = (r >> 4) * 2 + (c >> 5), rr = r & 15, cc = c & 31, ob = rr * 64 + cc * 2; return st * 1024 + (ob ^ (((ob >> 9) & 1) << 5)); }
__host__ __device__ __forceinline__ void stage_rc(int b, int& R, int& C) { const int st = b / 1024, sb = b % 1024, swz = sb ^ (((sb >> 9) & 1) << 5); R = (st >> 1) * 16 + swz / 64; C = (st & 1) * 32 + (swz % 64) / 2; }
__host__ __device__ __forceinline__ int perm32(int rho) { const int n = rho >> 4, i = rho & 15; return 8 * (i >> 2) + 4 * n + (i & 3); }

struct Unit { int pm, pn, po; };
struct Gemm { const bf16_t* A; const bf16_t* Bt; int K; };

struct StaticOrder {
    int nM, nN, nwg, G, c;
    __device__ __forceinline__ void init(int M, int N, int G_, int c_) { nM = M / BM; nN = N / BM; nwg = nM * nN; G = G_; c = c_; }
    __device__ __forceinline__ bool next(int i, Unit& u) const {
        const long L = (long)i * G + c; if (L >= nwg) return false;
        int wgid = (int)L; { const int q = nwg / NXCD, r = nwg % NXCD, xcd = wgid % NXCD, off = wgid / NXCD; wgid = (xcd < r ? xcd * (q + 1) : r * (q + 1) + (xcd - r) * q) + off; }
        const int nig = WGM * nN, gid = wgid / nig, fm = gid * WGM, gsz = (nM - fm) < WGM ? (nM - fm) : WGM;
        u.pm = fm + ((wgid % nig) % gsz); u.pn = (wgid % nig) / gsz; u.po = u.pn; return true;
    }
};
struct MoeOrder {
    int ppe, nN, nun, G, c;
    __device__ __forceinline__ void init(int ppe_, int nN_, int G_, int vcu) { ppe = ppe_; nN = nN_; nun = NE * ppe_ * nN_; G = G_; c = vcu; }
    __device__ __forceinline__ bool next(int i, Unit& u) const {
        const int L = i * G + c; if (L >= nun) return false;
        const int per = ppe * nN, e = L / per, r = L % per, pl = r % ppe, pn = r / ppe;
        u.pm = e * 9 + pl; u.pn = e * nN + pn; u.po = pn; return true;
    }
};

__device__ __forceinline__ unsigned cvt_pk_bf16(float lo, float hi) { return pk2(lo, hi); }

struct EpiBf16 {
    static constexpr bool PERM = true;
    bf16_t* O; int ldc;
    __device__ __forceinline__ void operator()(const f32x4 (&acc)[2][2][4][2], const Unit& u, int wr, int wc, int fr, int fq) const {
        const int row0 = u.pm * BM + wr * 64 + fr, col0 = u.po * BM + wc * 32 + 8 * fq;
#pragma unroll
        for (int ai = 0; ai < 2; ++ai)
#pragma unroll
            for (int m = 0; m < 4; ++m) { bf16_t* rowp = O + (size_t)(row0 + ai * HALF + m * 16) * ldc + col0;
#pragma unroll
                for (int bj = 0; bj < 2; ++bj) { const f32x4 v0 = acc[ai][bj][m][0], v1 = acc[ai][bj][m][1];
                    u32x4 w; w.x = cvt_pk_bf16(v0[0], v0[1]); w.y = cvt_pk_bf16(v0[2], v0[3]); w.z = cvt_pk_bf16(v1[0], v1[1]); w.w = cvt_pk_bf16(v1[2], v1[3]);
                    *(u32x4*)(rowp + bj * HALF) = w; } }
    }
};
struct EpiSwiglu {
    static constexpr bool PERM = true;
    bf16_t* O; int ldc;
    __device__ __forceinline__ void operator()(const f32x4 (&acc)[2][2][4][2], const Unit& u, int wr, int wc, int fr, int fq) const {
        const int row0 = u.pm * BM + wr * 64 + fr, col0 = u.po * HALF + wc * 32 + 8 * fq;
#pragma unroll
        for (int ai = 0; ai < 2; ++ai)
#pragma unroll
            for (int m = 0; m < 4; ++m) { bf16_t* rowp = O + (size_t)(row0 + ai * HALF + m * 16) * ldc + col0;
                float h[8];
#pragma unroll
                for (int n = 0; n < 2; ++n)
#pragma unroll
                    for (int j = 0; j < 4; ++j) { const float g = acc[ai][0][m][n][j], up = acc[ai][1][m][n][j];
                        h[n * 4 + j] = g * __builtin_amdgcn_rcpf(1.0f + __expf(-g)) * up; }
                u32x4 w; w.x = cvt_pk_bf16(h[0], h[1]); w.y = cvt_pk_bf16(h[2], h[3]); w.z = cvt_pk_bf16(h[4], h[5]); w.w = cvt_pk_bf16(h[6], h[7]);
                *(u32x4*)rowp = w; }
    }
};
struct EpiResGate {
    static constexpr bool PERM = true;
    bf16_t* X; const float* modl;
    __device__ __forceinline__ void operator()(const f32x4 (&acc)[2][2][4][2], const Unit& u, int wr, int wc, int fr, int fq) const {
        const int row0 = u.pm * BM + wr * 64 + fr, col0 = u.po * BM + wc * 32 + 8 * fq;
        const int ms = u.pm < 32 ? 0 : (u.pm < 64 ? 1 : 2);
        const float* gp = modl + ms * 6144 + 2048 + col0;
        f32x4 gv[2][2];
#pragma unroll
        for (int bj = 0; bj < 2; ++bj)
#pragma unroll
            for (int n = 0; n < 2; ++n) gv[bj][n] = *(const f32x4*)(gp + bj * HALF + n * 4);
#pragma unroll
        for (int ai = 0; ai < 2; ++ai) {
            bf16_t* rowp = X + (size_t)(row0 + ai * HALF) * D + col0;
            u32x4 xv[8];
#pragma unroll
            for (int m = 0; m < 4; ++m)
#pragma unroll
                for (int bj = 0; bj < 2; ++bj) xv[m * 2 + bj] = *(const u32x4*)(rowp + (size_t)m * 16 * D + bj * HALF);
            asm volatile("" : "+v"(xv[0]), "+v"(xv[1]), "+v"(xv[2]), "+v"(xv[3]), "+v"(xv[4]), "+v"(xv[5]), "+v"(xv[6]), "+v"(xv[7]) :: "memory");
#pragma unroll
            for (int m = 0; m < 4; ++m)
#pragma unroll
                for (int bj = 0; bj < 2; ++bj) { const u32x4 x = xv[m * 2 + bj]; const f32x4 a0 = acc[ai][bj][m][0], a1 = acc[ai][bj][m][1], g0 = gv[bj][0], g1 = gv[bj][1];
                    u32x4 w;
                    w.x = cvt_pk_bf16(__uint_as_float(x.x << 16) + g0[0] * a0[0], __uint_as_float(x.x & 0xffff0000u) + g0[1] * a0[1]);
                    w.y = cvt_pk_bf16(__uint_as_float(x.y << 16) + g0[2] * a0[2], __uint_as_float(x.y & 0xffff0000u) + g0[3] * a0[3]);
                    w.z = cvt_pk_bf16(__uint_as_float(x.z << 16) + g1[0] * a1[0], __uint_as_float(x.z & 0xffff0000u) + g1[1] * a1[1]);
                    w.w = cvt_pk_bf16(__uint_as_float(x.w << 16) + g1[2] * a1[2], __uint_as_float(x.w & 0xffff0000u) + g1[3] * a1[3]);
                    *(u32x4*)(rowp + (size_t)m * 16 * D + bj * HALF) = w; }
        }
    }
};

template <class Epi, class Sched>
__device__ __forceinline__ void gemm_phase(LAS unsigned char* lds, const int tid, const Gemm g, const Sched& S, const Epi& E) {
    const int wid = __builtin_amdgcn_readfirstlane(tid >> 6), lane = tid & 63, wr = wid >> 2, wc = wid & 3, fr = lane & 15, fq = lane >> 4;
    const int K = g.K, nt = K / BK;
    unsigned voffA[2], voffB[2];
#pragma unroll
    for (int i = 0; i < 2; ++i) { int R, C; stage_rc(tid * 16 + i * 8192, R, C); const int Rb = Epi::PERM ? ((R & ~31) + perm32(R & 31)) : R;
        voffA[i] = (unsigned)(R * K + C) * 2u; voffB[i] = (unsigned)(Rb * K + C) * 2u; }
    const size_t kstep = (size_t)(BK * 2);
    const size_t hstep = (size_t)HALF * K * 2;
    const size_t tstep = 2 * hstep;
    const unsigned ldsw = (unsigned)wid * 1024u;
    const int aoff = lds_byte(wr * 64 + fr, fq * 8), boff = lds_byte(wc * 32 + fr, fq * 8);
#define PG8_SA(b, h) (((b) * 2 + (h)) * HTB)
#define PG8_SB(b, h) ((4 + (b) * 2 + (h)) * HTB)
#define PG8_STAGE(bufoff, gbase, voff) do { _Pragma("unroll") for (int _i = 0; _i < 2; ++_i) \
        __builtin_amdgcn_global_load_lds((const unsigned*)((const char*)(gbase) + (voff)[_i]), (LAS unsigned*)(lds + (bufoff) + ldsw + _i * 8192), 16, 0, 0); } while (0)
#define PG8_LDA(dst, b, h) do { _Pragma("unroll") for (int m = 0; m < 4; ++m) _Pragma("unroll") for (int k = 0; k < 2; ++k) dst[m][k] = *(const LAS bf16x8*)(lds + PG8_SA(b, h) + aoff + m * 2048 + k * 1024); } while (0)
#define PG8_LDB(dst, b, h) do { _Pragma("unroll") for (int n = 0; n < 2; ++n) _Pragma("unroll") for (int k = 0; k < 2; ++k) dst[n][k] = *(const LAS bf16x8*)(lds + PG8_SB(b, h) + boff + n * 2048 + k * 1024); } while (0)
#define PG8_MMA(ai, bj, At, Bt) do { __builtin_amdgcn_s_setprio(1); _Pragma("unroll") for (int m = 0; m < 4; ++m) _Pragma("unroll") for (int n = 0; n < 2; ++n) _Pragma("unroll") for (int k = 0; k < 2; ++k) \
        acc[ai][bj][m][n] = __builtin_amdgcn_mfma_f32_16x16x32_bf16(Bt[n][k], At[m][k], acc[ai][bj][m][n], 0, 0, 0); __builtin_amdgcn_s_setprio(0); } while (0)
#define PG8_WAIT_V(n) asm volatile("s_waitcnt vmcnt(" #n ")" ::: "memory")
#define PG8_WAIT_L(n) asm volatile("s_waitcnt lgkmcnt(" #n ")" ::: "memory")
#define PG8_BAR __builtin_amdgcn_s_barrier()
#define PG8_SCHED __builtin_amdgcn_sched_barrier(0)
    Unit cur, nxt; int ui = 0;
    if (!S.next(0, cur)) return;
    f32x4 acc[2][2][4][2];
#pragma unroll
    for (int a = 0; a < 2; ++a)
#pragma unroll
        for (int b = 0; b < 2; ++b)
#pragma unroll
            for (int m = 0; m < 4; ++m)
#pragma unroll
                for (int n = 0; n < 2; ++n) acc[a][b][m][n] = (f32x4){0.f, 0.f, 0.f, 0.f};
    bf16x8 At[4][2], B0[2][2], B1[2][2];
    const char* cA = (const char*)g.A + (size_t)cur.pm * tstep; const char* cB = (const char*)g.Bt + (size_t)cur.pn * tstep;
    PG8_STAGE(PG8_SB(0, 0), cB, voffB); PG8_STAGE(PG8_SA(0, 0), cA, voffA); PG8_STAGE(PG8_SB(0, 1), cB + hstep, voffB); PG8_STAGE(PG8_SA(0, 1), cA + hstep, voffA);
    if (wr == 1) PG8_BAR;
    PG8_WAIT_V(4); PG8_BAR;
    PG8_STAGE(PG8_SB(1, 0), cB + kstep, voffB); PG8_STAGE(PG8_SA(1, 0), cA + kstep, voffA); PG8_STAGE(PG8_SB(1, 1), cB + hstep + kstep, voffB);
    PG8_WAIT_V(6); PG8_BAR;
    for (;;) {
        const bool has_next = S.next(ui + 1, nxt);
        const char* nA = has_next ? (const char*)g.A + (size_t)nxt.pm * tstep : cA; const char* nB = has_next ? (const char*)g.Bt + (size_t)nxt.pn * tstep : cB;
        for (int t = 0; t < nt; t += 2) {
            const bool last = (t == nt - 2);
            const char* a1 = cA + (size_t)(t + 1) * kstep;
            const char* a2 = last ? nA : cA + (size_t)(t + 2) * kstep; const char* b2 = last ? nB : cB + (size_t)(t + 2) * kstep;
            const char* a3 = a2 + kstep; const char* b3 = b2 + kstep;
            PG8_LDB(B0, 0, 0); PG8_SCHED; PG8_LDA(At, 0, 0); PG8_STAGE(PG8_SA(1, 1), a1 + hstep, voffA);
            PG8_WAIT_L(8); PG8_BAR; PG8_WAIT_L(0); PG8_MMA(0, 0, At, B0); PG8_BAR; PG8_SCHED;
            PG8_LDB(B1, 0, 1); PG8_STAGE(PG8_SB(0, 0), b2, voffB);
            PG8_BAR; PG8_WAIT_L(0); PG8_MMA(0, 1, At, B1); PG8_BAR;
            PG8_LDA(At, 0, 1); PG8_STAGE(PG8_SA(0, 0), a2, voffA);
            PG8_BAR; PG8_WAIT_L(0); PG8_MMA(1, 0, At, B0); PG8_BAR; PG8_SCHED;
            PG8_STAGE(PG8_SB(0, 1), b2 + hstep, voffB);
            PG8_WAIT_V(6); PG8_BAR; PG8_MMA(1, 1, At, B1); PG8_BAR;
            PG8_LDB(B0, 1, 0); PG8_SCHED; PG8_LDA(At, 1, 0); PG8_STAGE(PG8_SA(0, 1), a2 + hstep, voffA);
            PG8_WAIT_L(8); PG8_BAR; PG8_WAIT_L(0); PG8_MMA(0, 0, At, B0); PG8_BAR; PG8_SCHED;
            PG8_LDB(B1, 1, 1); PG8_STAGE(PG8_SB(1, 0), b3, voffB);
            PG8_BAR; PG8_WAIT_L(0); PG8_MMA(0, 1, At, B1); PG8_BAR;
            PG8_LDA(At, 1, 1); PG8_STAGE(PG8_SA(1, 0), a3, voffA);
            PG8_BAR; PG8_WAIT_L(0); PG8_MMA(1, 0, At, B0); PG8_BAR; PG8_SCHED;
            PG8_STAGE(PG8_SB(1, 1), b3 + hstep, voffB);
            PG8_WAIT_V(6); PG8_BAR; PG8_MMA(1, 1, At, B1); PG8_BAR;
        }
        E(acc, cur, wr, wc, fr, fq);
        if (!has_next) break;
#pragma unroll
        for (int a = 0; a < 2; ++a)
#pragma unroll
            for (int b = 0; b < 2; ++b)
#pragma unroll
                for (int m = 0; m < 4; ++m)
#pragma unroll
                    for (int n = 0; n < 2; ++n) acc[a][b][m][n] = (f32x4){0.f, 0.f, 0.f, 0.f};
        cur = nxt; cA = nA; cB = nB; ++ui;
    }
    PG8_WAIT_V(0);
    if (wr == 0) PG8_BAR;
    PG8_BAR;
#undef PG8_SA
#undef PG8_SB
#undef PG8_STAGE
#undef PG8_LDA
#undef PG8_LDB
#undef PG8_MMA
#undef PG8_WAIT_V
#undef PG8_WAIT_L
#undef PG8_BAR
#undef PG8_SCHED
}
template <class Epi, class Sched>
__device__ __forceinline__ void gemm_phase_gather(LAS unsigned char* lds, const int tid, const Gemm g, const Sched& S, const Epi& E, const LAS int* idxl) {
    const int wid = __builtin_amdgcn_readfirstlane(tid >> 6), lane = tid & 63, wr = wid >> 2, wc = wid & 3, fr = lane & 15, fq = lane >> 4;
    const int K = g.K, nt = K / BK;
    unsigned voffA[2], voffB[2];
#pragma unroll
    for (int i = 0; i < 2; ++i) { int R, C; stage_rc(tid * 16 + i * 8192, R, C); const int Rb = Epi::PERM ? ((R & ~31) + perm32(R & 31)) : R;
        voffA[i] = (unsigned)(R * K + C) * 2u; voffB[i] = (unsigned)(Rb * K + C) * 2u; }
    unsigned gcur[2][2];
#define PG8_GOFF(dst, unit) do { int _tz = tid; asm volatile("" : "+v"(_tz)); _Pragma("unroll") for (int _i = 0; _i < 2; ++_i) { int _R, _C; stage_rc(_tz * 16 + _i * 8192, _R, _C); \
        _Pragma("unroll") for (int _h = 0; _h < 2; ++_h) dst[_h][_i] = (unsigned)idxl[(unit) * 256 + _h * HALF + _R] * (unsigned)(K * 2) + (unsigned)_C * 2u; } } while (0)
    const size_t kstep = (size_t)(BK * 2);
    const size_t hstep = (size_t)HALF * K * 2;
    const size_t tstep = 2 * hstep;
    const unsigned ldsw = (unsigned)wid * 1024u;
    const int aoff = lds_byte(wr * 64 + fr, fq * 8), boff = lds_byte(wc * 32 + fr, fq * 8);
#define PG8_SA(b, h) (((b) * 2 + (h)) * HTB)
#define PG8_SB(b, h) ((4 + (b) * 2 + (h)) * HTB)
#define PG8_STAGE(bufoff, gbase, voff) do { _Pragma("unroll") for (int _i = 0; _i < 2; ++_i) \
        __builtin_amdgcn_global_load_lds((const unsigned*)((const char*)(gbase) + (voff)[_i]), (LAS unsigned*)(lds + (bufoff) + ldsw + _i * 8192), 16, 0, 0); } while (0)
#define PG8_LDA(dst, b, h) do { _Pragma("unroll") for (int m = 0; m < 4; ++m) _Pragma("unroll") for (int k = 0; k < 2; ++k) dst[m][k] = *(const LAS bf16x8*)(lds + PG8_SA(b, h) + aoff + m * 2048 + k * 1024); } while (0)
#define PG8_LDB(dst, b, h) do { _Pragma("unroll") for (int n = 0; n < 2; ++n) _Pragma("unroll") for (int k = 0; k < 2; ++k) dst[n][k] = *(const LAS bf16x8*)(lds + PG8_SB(b, h) + boff + n * 2048 + k * 1024); } while (0)
#define PG8_MMA(ai, bj, At, Bt) do { __builtin_amdgcn_s_setprio(1); _Pragma("unroll") for (int m = 0; m < 4; ++m) _Pragma("unroll") for (int n = 0; n < 2; ++n) _Pragma("unroll") for (int k = 0; k < 2; ++k) \
        acc[ai][bj][m][n] = __builtin_amdgcn_mfma_f32_16x16x32_bf16(Bt[n][k], At[m][k], acc[ai][bj][m][n], 0, 0, 0); __builtin_amdgcn_s_setprio(0); } while (0)
#define PG8_WAIT_V(n) asm volatile("s_waitcnt vmcnt(" #n ")" ::: "memory")
#define PG8_WAIT_L(n) asm volatile("s_waitcnt lgkmcnt(" #n ")" ::: "memory")
#define PG8_BAR __builtin_amdgcn_s_barrier()
#define PG8_SCHED __builtin_amdgcn_sched_barrier(0)
    Unit cur, nxt; int ui = 0;
    if (!S.next(0, cur)) return;
    f32x4 acc[2][2][4][2];
#pragma unroll
    for (int a = 0; a < 2; ++a)
#pragma unroll
        for (int b = 0; b < 2; ++b)
#pragma unroll
            for (int m = 0; m < 4; ++m)
#pragma unroll
                for (int n = 0; n < 2; ++n) acc[a][b][m][n] = (f32x4){0.f, 0.f, 0.f, 0.f};
    bf16x8 At[4][2], B0[2][2], B1[2][2];
    const char* const A0 = (const char*)g.A; const char* cB = (const char*)g.Bt + (size_t)cur.pn * tstep;
    PG8_GOFF(gcur, 0);
    PG8_STAGE(PG8_SB(0, 0), cB, voffB); PG8_STAGE(PG8_SA(0, 0), A0, gcur[0]); PG8_STAGE(PG8_SB(0, 1), cB + hstep, voffB); PG8_STAGE(PG8_SA(0, 1), A0, gcur[1]);
    if (wr == 1) PG8_BAR;
    PG8_WAIT_V(4); PG8_BAR;
    PG8_STAGE(PG8_SB(1, 0), cB + kstep, voffB); PG8_STAGE(PG8_SA(1, 0), A0 + kstep, gcur[0]); PG8_STAGE(PG8_SB(1, 1), cB + hstep + kstep, voffB);
    PG8_WAIT_V(6); PG8_BAR;
    for (;;) {
        const bool has_next = S.next(ui + 1, nxt);
        const char* nB = has_next ? (const char*)g.Bt + (size_t)nxt.pn * tstep : cB;
        for (int t = 0; t < nt; t += 2) {
            const bool last = (t == nt - 2);
            const char* a1 = A0 + (size_t)(t + 1) * kstep;
            const char* a2 = last ? A0 : A0 + (size_t)(t + 2) * kstep; const char* b2 = last ? nB : cB + (size_t)(t + 2) * kstep;
            unsigned sel[2][2];
            if (last && has_next) { PG8_GOFF(sel, ui + 1); } else { sel[0][0] = gcur[0][0]; sel[0][1] = gcur[0][1]; sel[1][0] = gcur[1][0]; sel[1][1] = gcur[1][1]; }
            const char* a3 = a2 + kstep; const char* b3 = b2 + kstep;
            PG8_LDB(B0, 0, 0); PG8_SCHED; PG8_LDA(At, 0, 0); PG8_STAGE(PG8_SA(1, 1), a1, gcur[1]);
            PG8_WAIT_L(8); PG8_BAR; PG8_WAIT_L(0); PG8_MMA(0, 0, At, B0); PG8_BAR; PG8_SCHED;
            PG8_LDB(B1, 0, 1); PG8_STAGE(PG8_SB(0, 0), b2, voffB);
            PG8_BAR; PG8_WAIT_L(0); PG8_MMA(0, 1, At, B1); PG8_BAR;
            PG8_LDA(At, 0, 1); PG8_STAGE(PG8_SA(0, 0), a2, sel[0]);
            PG8_BAR; PG8_WAIT_L(0); PG8_MMA(1, 0, At, B0); PG8_BAR; PG8_SCHED;
            PG8_STAGE(PG8_SB(0, 1), b2 + hstep, voffB);
            PG8_WAIT_V(6); PG8_BAR; PG8_MMA(1, 1, At, B1); PG8_BAR;
            PG8_LDB(B0, 1, 0); PG8_SCHED; PG8_LDA(At, 1, 0); PG8_STAGE(PG8_SA(0, 1), a2, sel[1]);
            PG8_WAIT_L(8); PG8_BAR; PG8_WAIT_L(0); PG8_MMA(0, 0, At, B0); PG8_BAR; PG8_SCHED;
            PG8_LDB(B1, 1, 1); PG8_STAGE(PG8_SB(1, 0), b3, voffB);
            PG8_BAR; PG8_WAIT_L(0); PG8_MMA(0, 1, At, B1); PG8_BAR;
            PG8_LDA(At, 1, 1); PG8_STAGE(PG8_SA(1, 0), a3, sel[0]);
            PG8_BAR; PG8_WAIT_L(0); PG8_MMA(1, 0, At, B0); PG8_BAR; PG8_SCHED;
            PG8_STAGE(PG8_SB(1, 1), b3 + hstep, voffB);
            PG8_WAIT_V(6); PG8_BAR; PG8_MMA(1, 1, At, B1); PG8_BAR;
        }
        E(acc, cur, wr, wc, fr, fq);
        if (!has_next) break;
#pragma unroll
        for (int a = 0; a < 2; ++a)
#pragma unroll
            for (int b = 0; b < 2; ++b)
#pragma unroll
                for (int m = 0; m < 4; ++m)
#pragma unroll
                    for (int n = 0; n < 2; ++n) acc[a][b][m][n] = (f32x4){0.f, 0.f, 0.f, 0.f};
        cur = nxt; cB = nB; ++ui;
        PG8_GOFF(gcur, ui);
    }
    PG8_WAIT_V(0);
    if (wr == 0) PG8_BAR;
    PG8_BAR;
#undef PG8_GOFF
#undef PG8_SA
#undef PG8_SB
#undef PG8_STAGE
#undef PG8_LDA
#undef PG8_LDB
#undef PG8_MMA
#undef PG8_WAIT_V
#undef PG8_WAIT_L
#undef PG8_BAR
#undef PG8_SCHED
}
}

struct Args { const float* in[29]; float* out; unsigned char* ws; int ph_lo, ph_hi; };
enum { I_X = 0, I_C, I_CTX, I_CCTX, I_WADA, I_BADA, I_N1G, I_N2G, I_WIN, I_WOUT, I_GWG, I_GBG, I_GNG, I_MNG, I_MWS, I_MBS, I_LCW, I_LCB, I_LWR, I_LBR, I_LWI, I_LBI, I_LLAM, I_RPB,
       I_WROUT, I_WGATE, I_WUP, I_WDOWN, I_FNG };

__device__ __forceinline__ const float* inp(const Args& A, int i) { asm volatile("" : "+s"(i)); return (const float*)(const GAS float*)A.in[i]; }
#define INP(i) inp(A, (i))

struct Frame {
    LAS unsigned char* lds;
    int tid, lane, wave, G, vcu, gw, NGW, bx;
    unsigned char* ws;
};
__device__ __forceinline__ Frame launder(const Frame& F0) {
    Frame F = F0;
    int tid = F0.tid, vcu = F0.vcu, G = F0.G, bx = F0.bx; GAS unsigned char* ws = (GAS unsigned char*)F0.ws;
    asm volatile("" : "+v"(tid)); asm volatile("" : "+s"(vcu)); asm volatile("" : "+s"(G)); asm volatile("" : "+s"(ws)); asm volatile("" : "+s"(bx));
    F.bx = bx; F.tid = tid; F.lane = tid & 63; F.wave = __builtin_amdgcn_readfirstlane(tid >> 6); F.vcu = vcu; F.G = G; F.ws = (unsigned char*)ws;
    F.gw = vcu * NWAVES + F.wave; F.NGW = G * NWAVES;
    return F;
}
__device__ __forceinline__ int row_set(int row) { return row < SEQ ? 0 : (row < 2 * SEQ ? 1 : (row < NLAT + CTX ? 2 : 3)); }
__device__ __forceinline__ int set_base(int set) { return set < 2 ? set * SEQ : NLAT + (set - 2) * CTX; }
__device__ __forceinline__ int chunk_row0(int b, int kk) { return kk < 4 ? NLAT + b * CTX + kk * 64 : b * SEQ + (kk - 4) * 64; }

__device__ __forceinline__ void cvt_block(const float* __restrict__ W, int N, int K, bf16_t* __restrict__ WT, size_t drow0, int k0, int n0, LAS float* scr, int lane) {
#pragma unroll
    for (int i = 0; i < 8; ++i) { const int kk = 8 * i + (lane >> 3), nn = (lane & 7) * 4;
        const f32x4 v = __builtin_nontemporal_load((const f32x4*)(W + (size_t)(k0 + kk) * N + n0 + nn));
        LAS float* s = scr + kk * 33 + nn; s[0] = v[0]; s[1] = v[1]; s[2] = v[2]; s[3] = v[3]; }
    LDS_WAIT();
    const int c = lane & 7;
#pragma unroll
    for (int j = 0; j < 4; ++j) { const int n = (lane >> 3) + 8 * j; const LAS float* s = scr + (8 * c) * 33 + n;
        u32x4 o; o.x = pk2(s[0 * 33], s[1 * 33]); o.y = pk2(s[2 * 33], s[3 * 33]); o.z = pk2(s[4 * 33], s[5 * 33]); o.w = pk2(s[6 * 33], s[7 * 33]);
        __builtin_nontemporal_store(o, (u32x4*)(WT + (drow0 + n) * (size_t)K + k0 + 8 * c));     }
    LDS_WAIT();
}
constexpr int CV_IN = 16 * 89, CV_OUT = 16 * 32, CV_G = 16 * 1024, CV_PER_L = CV_IN + CV_OUT + 3 * CV_G;
__device__ __forceinline__ void cvt_item(const Frame& F, const Args& A, int l, int r, LAS float* scr) {
    bf16_t* win_t = (bf16_t*)(F.ws + WS_WIN); bf16_t* wout_t = (bf16_t*)(F.ws + WS_WOUT); bf16_t* w1_t = (bf16_t*)(F.ws + WS_W1); bf16_t* w2_t = (bf16_t*)(F.ws + WS_W2);
    if (r < CV_IN) { const int kb = r / 89, nb = r % 89, n0 = nb * 32; const size_t dr = n0 < 1024 ? n0 : (n0 < 1056 ? 2816 : n0 - 32);
        cvt_block(INP(I_WIN) + (size_t)l * D * INC, INC, D, win_t + (size_t)l * INC * D, dr, kb * 64, n0, scr, F.lane); return; }
    r -= CV_IN;
    if (r < CV_OUT) { const int kb = r / 32, nb = r % 32; cvt_block(INP(I_WOUT) + (size_t)l * D * D, D, D, wout_t + (size_t)l * D * D, nb * 32, kb * 64, nb * 32, scr, F.lane); return; }
    r -= CV_OUT;
    if (r < 2 * CV_G) { const int up = r >= CV_G; if (up) r -= CV_G; const int e = r / 1024, q = r % 1024, kb = q / 64, nb = q % 64, n0 = nb * 32;
        const size_t dr = (size_t)e * 4096 + 256 * (n0 >> 7) + (n0 & 127) + (up ? 128 : 0);
        cvt_block((up ? INP(I_WUP) : INP(I_WGATE)) + (size_t)(l * NE + e) * D * FF, FF, D, w1_t + (size_t)l * NE * 4096 * D, dr, kb * 64, n0, scr, F.lane); return; }
    r -= 2 * CV_G;
    { const int e = r / 1024, q = r % 1024, kb = q / 32, nb = q % 32, n0 = nb * 32;
        cvt_block(INP(I_WDOWN) + (size_t)(l * NE + e) * FF * D, D, FF, w2_t + (size_t)l * NE * D * FF, (size_t)e * 1024 + n0, kb * 64, n0, scr, F.lane); }
}
struct CvtDesc { const float* W; bf16_t* WT; size_t dr; int N, K, k0, n0; };
__device__ __forceinline__ CvtDesc cvt_decode_moe(const Frame& F, const Args& A, int l, int r) {
    CvtDesc c; r -= CV_IN + CV_OUT;
    if (r < 2 * CV_G) { const int up = r >= CV_G; if (up) r -= CV_G; const int e = r / 1024, q = r % 1024, kb = q / 64, nb = q % 64, n0 = nb * 32;
        c.W = (up ? INP(I_WUP) : INP(I_WGATE)) + (size_t)(l * NE + e) * D * FF; c.WT = (bf16_t*)(F.ws + WS_W1) + (size_t)l * NE * 4096 * D; c.dr = (size_t)e * 4096 + 256 * (n0 >> 7) + (n0 & 127) + (up ? 128 : 0);
        c.N = FF; c.K = D; c.k0 = kb * 64; c.n0 = n0; return c; }
    r -= 2 * CV_G;
    { const int e = r / 1024, q = r % 1024, kb = q / 32, nb = q % 32, n0 = nb * 32;
        c.W = INP(I_WDOWN) + (size_t)(l * NE + e) * FF * D; c.WT = (bf16_t*)(F.ws + WS_W2) + (size_t)l * NE * D * FF; c.dr = (size_t)e * 1024 + n0; c.N = D; c.K = FF; c.k0 = kb * 64; c.n0 = n0; return c; }
}
constexpr int CQ4 = 40, CQ8 = 80, CQ3 = 24, CQ6 = 0;
constexpr int CB4 = 0, CB8 = CB4 + 248 * CQ4, CB3 = CB8 + 192 * CQ8, CB6 = CB3 + 126 * CQ3, CB_P5 = CB6 + 96 * CQ6, CQ5 = 8, CB_DRAIN = CB_P5 + CQ5 * 2048;
static_assert(CB_DRAIN <= CV_PER_L && CB3 >= CV_IN + CV_OUT, "conversion quotas");
__device__ __forceinline__ void cvt_issue(const CvtDesc& c, int lane, f32x4 (&v)[8]) {
#pragma unroll
    for (int i = 0; i < 8; ++i) { const int kk = 8 * i + (lane >> 3), nn = (lane & 7) * 4; v[i] = __builtin_nontemporal_load((const f32x4*)(c.W + (size_t)(c.k0 + kk) * c.N + c.n0 + nn)); }
}
__device__ __forceinline__ void cvt_finish(const CvtDesc& c, int lane, const f32x4 (&v)[8], LAS float* scr) {
#pragma unroll
    for (int i = 0; i < 8; ++i) { const int kk = 8 * i + (lane >> 3), nn = (lane & 7) * 4; LAS float* sp = scr + kk * 33 + nn; sp[0] = v[i][0]; sp[1] = v[i][1]; sp[2] = v[i][2]; sp[3] = v[i][3]; }
    LDS_WAIT();
    const int cc = lane & 7;
#pragma unroll
    for (int j = 0; j < 4; ++j) { const int n = (lane >> 3) + 8 * j; const LAS float* sp = scr + (8 * cc) * 33 + n;
        u32x4 o; o.x = pk2(sp[0 * 33], sp[1 * 33]); o.y = pk2(sp[2 * 33], sp[3 * 33]); o.z = pk2(sp[4 * 33], sp[5 * 33]); o.w = pk2(sp[6 * 33], sp[7 * 33]);
        *(u32x4*)(c.WT + (c.dr + n) * (size_t)c.K + c.k0 + 8 * cc) = o; }
    LDS_WAIT();
}
template <int NB>
__device__ __forceinline__ void cvt_group_moe(const Frame& F, const Args& A, int l, int r, int stride, LAS float* scr) {
    CvtDesc c[NB]; f32x4 v[NB][8];
#pragma unroll
    for (int b = 0; b < NB; ++b) { c[b] = cvt_decode_moe(F, A, l, r + b * stride); cvt_issue(c[b], F.lane, v[b]); }
    asm volatile("" ::: "memory");
#pragma unroll
    for (int b = 0; b < NB; ++b) cvt_finish(c[b], F.lane, v[b], scr);
}
__device__ __forceinline__ void cvt_stream_moe(const Frame& F, const Args& A, int l, int first, int end, int stride, LAS float* scr) {
    int r = first;
    for (; r + 3 * stride < end; r += 4 * stride) cvt_group_moe<4>(F, A, l, r, stride, scr);
    if (r + 2 * stride < end) { cvt_group_moe<3>(F, A, l, r, stride, scr); return; }
    if (r + stride < end) { cvt_group_moe<2>(F, A, l, r, stride, scr); return; }
    if (r < end) cvt_group_moe<1>(F, A, l, r, stride, scr);
}
__device__ __forceinline__ void cvt_range(const Frame& F, const Args& A, int l, int first, int count) {
    LAS float* scr = (LAS float*)(F.lds) + F.wave * (64 * 33);
    for (int r = first + F.wave; r < first + count; r += NWAVES) cvt_item(F, A, l, r, scr);
}
constexpr int ADA_ITEMS = DEPTH * 8 * 96;
constexpr int LRUW_ITEMS = DEPTH * 16;
__device__ __forceinline__ void p0_prologue(Frame& F, const Args& A) {
    LAS float* scr = (LAS float*)(F.lds) + F.wave * (64 * 33);
    LAS float* sil = (LAS float*)(F.lds + 8 * 64 * 33 * 4);
    for (int i = F.tid; i < 3 * D; i += 512) { const float v = i < 2 * D ? INP(I_C)[i] : INP(I_CCTX)[i - 2 * D]; sil[i] = siluf_(v); }
    __syncthreads();
    float* modp = (float*)(F.ws + WS_MODP);
    bf16_t* win_t = (bf16_t*)(F.ws + WS_WIN); bf16_t* wout_t = (bf16_t*)(F.ws + WS_WOUT); bf16_t* w1_t = (bf16_t*)(F.ws + WS_W1); bf16_t* w2_t = (bf16_t*)(F.ws + WS_W2);
    for (int i8 = F.gw * 64 + F.lane; i8 < DEPTH * 4 * 128 * 128 / 8; i8 += F.NGW * 64) {
        const f32x4 a = *(const f32x4*)(INP(I_MWS) + (size_t)i8 * 8), b = *(const f32x4*)(INP(I_MWS) + (size_t)i8 * 8 + 4);
        u32x4 o; o.x = pk2(a[0], a[1]); o.y = pk2(a[2], a[3]); o.z = pk2(b[0], b[1]); o.w = pk2(b[2], b[3]);
        *(u32x4*)((bf16_t*)(F.ws + WS_MWS) + (size_t)i8 * 8) = o; }
    for (int idx = F.gw * 64 + F.lane; idx < 128 * 16; idx += F.NGW * 64) { const float ang = (float)(idx >> 4) * rope_inv(idx & 15); float sn, cs; sincosf(ang, &sn, &cs);
        ((f32x2*)(F.ws + WS_ROPE))[idx] = (f32x2){cs, sn}; }
    const int total = ADA_ITEMS + CV_PER_L + LRUW_ITEMS;
    for (int it = F.gw; it < total; it += F.NGW) {
        if (it >= ADA_ITEMS + CV_PER_L) {
            const int m = it - (ADA_ITEMS + CV_PER_L), l = m >> 4, q = m & 15, d = q >> 3, gate = (q >> 2) & 1, g = q & 3;
            const float* W = (gate ? INP(I_LWI) : INP(I_LWR)) + ((size_t)((l * 2 + d) * 4 + g) * 64) * 64 + F.lane;
            bf16_t* WT = (bf16_t*)(F.ws + WS_LRUW) + ((size_t)(((l * 2 + d) * 2 + gate) * 4 + g) * 64 + F.lane) * 64;
#pragma unroll
            for (int c = 0; c < 8; ++c) { float v[8];
#pragma unroll
                for (int u = 0; u < 8; ++u) v[u] = W[(size_t)(8 * c + u) * 64];
                u32x4 o; o.x = pk2(v[0], v[1]); o.y = pk2(v[2], v[3]); o.z = pk2(v[4], v[5]); o.w = pk2(v[6], v[7]);
                *(u32x4*)(WT + 8 * c) = o; }
            continue;
        }
        if (it < ADA_ITEMS) {
            const int l = it / 768, r = it % 768, p = r / 96, cb = r % 96, j = cb * 64 + F.lane, k0 = p * 128;
            const float* w = INP(I_WADA) + ((size_t)l * D + k0) * 6144 + j;
            float s0 = 0.f, s1 = 0.f, s2 = 0.f;
#pragma unroll 32
            for (int k = 0; k < 128; ++k) { const float wv = w[(size_t)k * 6144]; s0 += sil[k0 + k] * wv; s1 += sil[D + k0 + k] * wv; s2 += sil[2 * D + k0 + k] * wv; }
            float* o = modp + ((size_t)(l * 8 + p) * 3) * 6144 + j;
            o[0] = s0; o[6144] = s1; o[2 * 6144] = s2;
            continue;
        }
        cvt_item(F, A, 0, it - ADA_ITEMS, scr);
    }
}

__device__ __forceinline__ float mod_val(const Frame& F, const Args& A, int l, int s, int j) {
    const float* modp = (const float*)(F.ws + WS_MODP) + ((size_t)(l * 8) * 3 + s) * 6144 + j;
    float v = INP(I_BADA)[l * 6144 + j];
#pragma unroll
    for (int p = 0; p < 8; ++p) v += modp[(size_t)p * 3 * 6144];
    return v;
}

__device__ __forceinline__ void p1_norm1(Frame& F, const Args& A, int l, bool dry = false) {
    if (l >= 1 && l < DEPTH && !dry) {
        LAS float* scr = (LAS float*)(F.lds + 65536) + F.wave * (64 * 33);
        if (F.G == 256) cvt_stream_moe(F, A, l, CB_DRAIN + F.gw, CV_PER_L, F.NGW, scr);
        else for (int r = F.gw; r < CV_PER_L; r += F.NGW) cvt_item(F, A, l, r, scr);
    }
    LAS float* sc = (LAS float*)F.lds;
    LAS float* sh = sc + 3 * D;
    LAS float* g2 = sh + 3 * D;
    LAS float* ng = g2 + 3 * D;
    const float* mod = (const float*)(F.ws + WS_MOD); float* modw = dry ? (float*)(F.ws + WS_HID + (size_t)120 * MiB) : (float*)(F.ws + WS_MOD);
    if (l == 0) { for (int i = F.tid; i < 3 * D; i += 512) { const int s = i >> 10, j = i & 1023; sh[i] = mod_val(F, A, l, s, j); sc[i] = 1.0f + mod_val(F, A, l, s, 1024 + j); } }
    else {
        f32x4 m[6];
#pragma unroll
        for (int u = 0; u < 2; ++u) { const int i4 = F.tid + 512 * u, i = 4 * i4, s = i >> 10, j = i & 1023; m[3 * u] = (f32x4){0.f, 0.f, 0.f, 0.f}; m[3 * u + 1] = m[3 * u]; m[3 * u + 2] = m[3 * u];
            if (i4 < 768) { if (l < DEPTH) { m[3 * u] = *(const f32x4*)(mod + ((size_t)l * 3 + s) * 6144 + j); m[3 * u + 1] = *(const f32x4*)(mod + ((size_t)l * 3 + s) * 6144 + 1024 + j); }
                m[3 * u + 2] = *(const f32x4*)(mod + ((size_t)(l - 1) * 3 + s) * 6144 + 5120 + j); } }
        pin6(m);
#pragma unroll
        for (int u = 0; u < 2; ++u) { const int i4 = F.tid + 512 * u, i = 4 * i4;
            if (i4 < 768) { if (l < DEPTH) { *(LAS f32x4*)(sh + i) = m[3 * u]; *(LAS f32x4*)(sc + i) = m[3 * u + 1] + 1.0f; } *(LAS f32x4*)(g2 + i) = m[3 * u + 2]; } } }
    if (F.tid < 256) *(LAS f32x4*)(ng + 4 * F.tid) = *(const f32x4*)((l < DEPTH ? INP(I_N1G) + l * D : INP(I_FNG)) + 4 * F.tid);
    if (l == 0) for (int i = F.bx * 512 + F.tid; i < DEPTH * 3 * 6144; i += F.G * 512) { const int ll = i / (3 * 6144), r = i % (3 * 6144); modw[i] = mod_val(F, A, ll, r / 6144, r % 6144); }
    __syncthreads();
    const bf16_t* X = (const bf16_t*)(F.ws + WS_X); bf16_t* Xw = dry ? (bf16_t*)(F.ws + WS_HID) : (bf16_t*)(F.ws + WS_X); bf16_t* H = dry ? (bf16_t*)(F.ws + WS_HID + (size_t)80 * MiB) : (bf16_t*)(F.ws + WS_H);
    float* outp = dry ? (float*)(F.ws + WS_HID) : A.out;
    const int* SLOT = (const int*)(F.ws + WS_SLOT); const float* GSEL = (const float*)(F.ws + WS_GSEL); const bf16_t* Y = (const bf16_t*)(F.ws + WS_Y);
    const int nrows = l < DEPTH ? MROWS : NLAT;
    const float* xin = INP(I_X); const float* cin = INP(I_CTX);
    u32x4 vr[4]; int slot = -1;
#pragma unroll
    for (int j = 0; j < 4; ++j) vr[j] = (u32x4){0u, 0u, 0u, 0u};
    { const int row = F.gw;
        if (row < nrows) { const int set = row_set(row), tok = row - set_base(set);
            if (l == 0) { const float* src = set < 2 ? xin + (size_t)row * D : cin + (size_t)(row - NLAT) * D;
#pragma unroll
                for (int j = 0; j < 4; ++j) vr[j] = *(const u32x4*)(src + 4 * F.lane + 256 * j); }
            else {
#pragma unroll
                for (int j = 0; j < 4; ++j) { const u32x2 t = *(const u32x2*)(X + (size_t)row * D + 4 * F.lane + 256 * j); vr[j].x = t.x; vr[j].y = t.y; } }
            if (l > 0 && F.lane < NE) slot = set < 2 ? SLOT[((size_t)set * NE + F.lane) * SEQ + tok] : SLOT[(size_t)2 * NE * SEQ + ((size_t)(set - 2) * NE + F.lane) * CTX + tok]; } }
    for (int row = F.gw; row < nrows; row += F.NGW) {
        const int set = row_set(row), ms = set < 2 ? set : 2;
        u32x4 nv[4]; int nslot = -1;
#pragma unroll
        for (int j = 0; j < 4; ++j) nv[j] = (u32x4){0u, 0u, 0u, 0u};
        { const int nrow = row + F.NGW;
            if (nrow < nrows) { const int nset = row_set(nrow), ntok = nrow - set_base(nset);
                if (l == 0) { const float* src = nset < 2 ? xin + (size_t)nrow * D : cin + (size_t)(nrow - NLAT) * D;
#pragma unroll
                    for (int j = 0; j < 4; ++j) nv[j] = *(const u32x4*)(src + 4 * F.lane + 256 * j); }
                else {
#pragma unroll
                    for (int j = 0; j < 4; ++j) { const u32x2 t = *(const u32x2*)(X + (size_t)nrow * D + 4 * F.lane + 256 * j); nv[j].x = t.x; nv[j].y = t.y; } }
                if (l > 0 && F.lane < NE) nslot = nset < 2 ? SLOT[((size_t)nset * NE + F.lane) * SEQ + ntok] : SLOT[(size_t)2 * NE * SEQ + ((size_t)(nset - 2) * NE + F.lane) * CTX + ntok]; } }
        f32x4 v[4];
#pragma unroll
        for (int j = 0; j < 4; ++j) v[j] = l == 0 ? (f32x4){__uint_as_float(vr[j].x), __uint_as_float(vr[j].y), __uint_as_float(vr[j].z), __uint_as_float(vr[j].w)}
                                                  : (f32x4){__uint_as_float(vr[j].x << 16), __uint_as_float(vr[j].x & 0xffff0000u), __uint_as_float(vr[j].y << 16), __uint_as_float(vr[j].y & 0xffff0000u)};
        if (l > 0) {
            unsigned long long m = __ballot(slot >= 0);
            f32x4 acc[4];
#pragma unroll
            for (int j = 0; j < 4; ++j) acc[j] = (f32x4){0.f, 0.f, 0.f, 0.f};
            const int xbase = set < 2 ? set * 1024 : 2048 + (set - 2) * 32;
            while (m) {
                const int e0 = __builtin_ctzll(m); m &= m - 1; const bool two = m != 0ull; const int e1 = two ? __builtin_ctzll(m) : e0; if (two) m &= m - 1;
                const int x0 = e0 * XS_PER_E + xbase + __shfl(slot, e0), x1 = e1 * XS_PER_E + xbase + __shfl(slot, e1);
                const float g0 = GSEL[x0], g1 = two ? GSEL[x1] : 0.f;
                const bf16_t* y0 = Y + (size_t)x0 * D + 4 * F.lane; const bf16_t* y1 = Y + (size_t)x1 * D + 4 * F.lane;
                u32x2 w0[4], w1[4];
#pragma unroll
                for (int j = 0; j < 4; ++j) { w0[j] = *(const u32x2*)(y0 + 256 * j); w1[j] = *(const u32x2*)(y1 + 256 * j); }
#pragma unroll
                for (int j = 0; j < 4; ++j) { acc[j][0] += g0 * bf2f(w0[j].x & 0xffffu); acc[j][1] += g0 * bf2f(w0[j].x >> 16); acc[j][2] += g0 * bf2f(w0[j].y & 0xffffu); acc[j][3] += g0 * bf2f(w0[j].y >> 16); }
#pragma unroll
                for (int j = 0; j < 4; ++j) { acc[j][0] += g1 * bf2f(w1[j].x & 0xffffu); acc[j][1] += g1 * bf2f(w1[j].x >> 16); acc[j][2] += g1 * bf2f(w1[j].y & 0xffffu); acc[j][3] += g1 * bf2f(w1[j].y >> 16); }
            }
#pragma unroll
            for (int j = 0; j < 4; ++j) { const f32x4 gg = *(const LAS f32x4*)(g2 + ms * D + 4 * F.lane + 256 * j); v[j] = v[j] + gg * acc[j]; }
        }
        if (l < DEPTH) {
#pragma unroll
            for (int j = 0; j < 4; ++j) { u32x2 w; w.x = pg8::cvt_pk_bf16(v[j][0], v[j][1]); w.y = pg8::cvt_pk_bf16(v[j][2], v[j][3]); __builtin_nontemporal_store(w, (u32x2*)(Xw + (size_t)row * D + 4 * F.lane + 256 * j)); }
        }
        float ss = 0.f;
#pragma unroll
        for (int j = 0; j < 4; ++j) ss += (v[j][0] * v[j][0] + v[j][1] * v[j][1]) + (v[j][2] * v[j][2] + v[j][3] * v[j][3]);
        const float rstd = __builtin_amdgcn_rsqf(wave_sum(ss) * (1.0f / D) + EPS);
        if (l < DEPTH) {
#pragma unroll
            for (int j = 0; j < 4; ++j) { const int c0 = 4 * F.lane + 256 * j;
                const f32x4 gn = *(const LAS f32x4*)(ng + c0), s1 = *(const LAS f32x4*)(sc + ms * D + c0), h1 = *(const LAS f32x4*)(sh + ms * D + c0);
                const f32x4 o = v[j] * rstd * gn * s1 + h1;
                u32x2 w; w.x = pg8::cvt_pk_bf16(o[0], o[1]); w.y = pg8::cvt_pk_bf16(o[2], o[3]);
                *(u32x2*)(H + (size_t)row * D + c0) = w; }
        } else {
#pragma unroll
            for (int j = 0; j < 4; ++j) { const int c0 = 4 * F.lane + 256 * j; const f32x4 gn = *(const LAS f32x4*)(ng + c0);
                __builtin_nontemporal_store(v[j] * rstd * gn, (f32x4*)(outp + (size_t)row * D + c0)); }
        }
#pragma unroll
        for (int j = 0; j < 4; ++j) vr[j] = nv[j];
        slot = nslot;
    }
}

__device__ __forceinline__ void p2_gate_feats(Frame& F, int l) {
    const bf16_t* H = (const bf16_t*)(F.ws + WS_H);
    const bf16_t* WG = (const bf16_t*)(F.ws + WS_WIN) + ((size_t)l * INC + PC) * D;
    float* Z = (float*)(F.ws + WS_Z);
    const int rem = (MROWS / 256 * (PC / 256)) % F.G, nidle = F.G - rem;
    if (F.bx < rem) return;
    constexpr int WP2 = 1032;
    LAS bf16_t* wl = (LAS bf16_t*)F.lds;
    { u32x4 wv[8];
#pragma unroll
        for (int u = 0; u < 8; ++u) { const int idx = F.tid + 512 * u, r = idx >> 7, c8 = (idx & 127) * 8; wv[u] = *(const u32x4*)(WG + (size_t)r * D + c8); }
#pragma unroll
        for (int u = 0; u < 8; ++u) { const int idx = F.tid + 512 * u, r = idx >> 7, c8 = (idx & 127) * 8; *(LAS u32x4*)(wl + r * WP2 + c8) = wv[u]; } }
    __syncthreads();
    const int fr = F.lane & 15, fq = F.lane >> 4;
    for (int tb = (F.bx - rem) * NWAVES + F.wave; tb < MROWS / 16; tb += nidle * NWAVES) {
        const int r0 = tb * 16;
        f32x4 a0 = (f32x4){0.f, 0.f, 0.f, 0.f}, a1 = a0;
        const bf16_t* ap = H + (size_t)(r0 + fr) * D + fq * 8;
        const LAS bf16_t* bp0 = wl + fr * WP2 + fq * 8; const LAS bf16_t* bp1 = wl + (16 + fr) * WP2 + fq * 8;
#pragma unroll 1
        for (int kb = 0; kb < 2; ++kb) {
            bf16x8 av[16];
#pragma unroll
            for (int u = 0; u < 16; ++u) av[u] = *(const bf16x8*)(ap + (kb * 16 + u) * 32);
            asm volatile("" : "+v"(av[0]), "+v"(av[1]), "+v"(av[2]), "+v"(av[3]), "+v"(av[4]), "+v"(av[5]), "+v"(av[6]), "+v"(av[7]),
                              "+v"(av[8]), "+v"(av[9]), "+v"(av[10]), "+v"(av[11]), "+v"(av[12]), "+v"(av[13]), "+v"(av[14]), "+v"(av[15]) :: "memory");
#pragma unroll
            for (int u = 0; u < 16; ++u) { a0 = __builtin_amdgcn_mfma_f32_16x16x32_bf16(av[u], *(const LAS bf16x8*)(bp0 + (kb * 16 + u) * 32), a0, 0, 0, 0);
                a1 = __builtin_amdgcn_mfma_f32_16x16x32_bf16(av[u], *(const LAS bf16x8*)(bp1 + (kb * 16 + u) * 32), a1, 0, 0, 0); }
        }
#pragma unroll
        for (int j = 0; j < 4; ++j) { Z[(size_t)(r0 + 4 * fq + j) * 32 + fr] = a0[j]; Z[(size_t)(r0 + 4 * fq + j) * 32 + 16 + fr] = a1[j]; }
    }
}


__device__ __forceinline__ void gla_load_gates_t(const Frame& F, const Args& A, int l, int h, int row0, LAS float* zs, LAS float* wg, LAS float* bg) {
    const float* Z = (const float*)(F.ws + WS_Z);
    for (int idx = F.tid; idx < 64 * 32; idx += 512) zs[idx] = Z[(size_t)row0 * 32 + idx];
    for (int idx = F.tid; idx < 2 * 16 * 64; idx += 512) { const int d = idx >> 10, r = (idx >> 6) & 15, dk = idx & 63; wg[(d * 64 + dk) * 16 + r] = INP(I_GWG)[((size_t)(l * 2 + d) * 16 + r) * 256 + h * 64 + dk]; }
    if (F.tid < 128) { const int d = F.tid >> 6, dk = F.tid & 63; bg[F.tid] = INP(I_GBG)[(size_t)(l * 2 + d) * 256 + h * 64 + dk]; }
}
__device__ __forceinline__ void t_gla_scan_e(Frame& F, int e);
__device__ __forceinline__ void t_gla_scan(Frame& F, int task, bool dry = false) { (void)dry; t_gla_scan_e(F, task * 512 + F.tid); }
__device__ __forceinline__ void t_gla_scan_e(Frame& F, int e) {
    const bool dry = false; const int dvk = e & 4095, chain = e >> 12;
    const int d = chain >> 3, dk = dvk & 63;
    const bf16_t* KV = (const bf16_t*)(F.ws + WS_KV) + (size_t)chain * NCH * 4096 + dvk; bf16_t* SS = (bf16_t*)(F.ws + WS_SS) + (size_t)chain * NCH * 4096 + dvk;
    const float* DEC = (const float*)(F.ws + WS_DEC) + (size_t)chain * NCH * 64 + dk;
    (void)dry;
    float S = 0.f;
    for (int n0 = 0; n0 < NCH; n0 += 22) {
        float dc[22]; unsigned kv[22]; int idx[22];
#pragma unroll
        for (int u = 0; u < 22; ++u) { const int n = n0 + u; idx[u] = d == 0 ? n : (n < 4 ? 3 - n : NCH - 1 - (n - 4)); kv[u] = KV[(size_t)idx[u] * 4096]; dc[u] = DEC[idx[u] * 64]; }
#pragma unroll
        for (int u = 0; u < 22; ++u) { SS[(size_t)idx[u] * 4096] = (bf16_t)f2bf(S); S = S * dc[u] + bf2f(kv[u]); }
    }
}
constexpr int GP = 72;
__device__ __forceinline__ float wave_incl_scan(float v) {
    v += __int_as_float(__builtin_amdgcn_update_dpp(0, __float_as_int(v), 0x111, 0xf, 0xf, true));
    v += __int_as_float(__builtin_amdgcn_update_dpp(0, __float_as_int(v), 0x112, 0xf, 0xf, true));
    v += __int_as_float(__builtin_amdgcn_update_dpp(0, __float_as_int(v), 0x114, 0xf, 0xf, true));
    v += __int_as_float(__builtin_amdgcn_update_dpp(0, __float_as_int(v), 0x118, 0xf, 0xf, true));
    v += __int_as_float(__builtin_amdgcn_update_dpp(0, __float_as_int(v), 0x142, 0xa, 0xf, false));
    v += __int_as_float(__builtin_amdgcn_update_dpp(0, __float_as_int(v), 0x143, 0xc, 0xf, false));
    return v;
}
__device__ __forceinline__ void t_gla_main(Frame& F, const Args& A, int l, int task, bool need_ctx) {
    const int h = task & 3, kk = (task >> 2) % NCH, b = task / (4 * NCH);
    const int row0 = chunk_row0(b, kk);
    const bool want_o = kk >= 4 || need_ctx;
    const bf16_t* P = (const bf16_t*)(F.ws + WS_P);
    constexpr int ZP = 36;
    LAS float* Bc = (LAS float*)F.lds; LAS float* zs = Bc + 2 * 64 * 65; LAS float* wg = zs + 64 * ZP; LAS float* bg = wg + 2 * 16 * 64;
    LAS bf16_t* QI = (LAS bf16_t*)(bg + 128);
    LAS bf16_t* KI = QI + 2 * 64 * GP;
    LAS bf16_t* KE = KI + 2 * 64 * GP;
    LAS bf16_t* VT = KE + 2 * 64 * GP;
    LAS float* OM = (LAS float*)(VT + 64 * GP);
    const int i = F.tid >> 3, sub = F.tid & 7, pc = sub >> 1, hf = sub & 1, c1 = pc < 2 ? pc : pc + 2, d0 = 8 * c1 + 4 * hf;
    const bf16_t* pr = P + (size_t)(row0 + i) * PC + h * 64 + d0;
    const u32x2 kA = *(const u32x2*)(pr + C_K), kB = *(const u32x2*)(pr + C_K + 16), vA = *(const u32x2*)(pr + C_V), vB = *(const u32x2*)(pr + C_V + 16);
    const u32x2 qA = *(const u32x2*)(pr + C_Q), qB = *(const u32x2*)(pr + C_Q + 16);
    f32x4 gl[4]; float bgv = 0.f;
    const int gd = F.tid >> 8, gr = (F.tid >> 4) & 15, gdk4 = (F.tid & 15) * 4;
    gl[0] = *(const f32x4*)((const float*)(F.ws + WS_Z) + (size_t)row0 * 32 + 4 * F.tid);
    gl[1] = *(const f32x4*)(INP(I_GWG) + ((size_t)(l * 2 + gd) * 16 + gr) * 256 + h * 64 + gdk4);
    gl[2] = (f32x4){0.f, 0.f, 0.f, 0.f}; gl[3] = gl[2];
    if (kk >= 4) { const int pos = pc < 2 ? kk - 4 : i; const int a = d0 & 15;
        const f32x4* rt = (const f32x4*)((const float*)(F.ws + WS_ROPE) + ((size_t)pos * 16 + a) * 2); gl[2] = rt[0]; gl[3] = rt[1]; }
    if (F.tid < 128) bgv = INP(I_GBG)[(size_t)(l * 2 + (F.tid >> 6)) * 256 + h * 64 + (F.tid & 63)];
    pin4(gl); pin1(bgv);
    *(LAS f32x4*)(zs + (F.tid >> 3) * ZP + 4 * (F.tid & 7)) = gl[0];
#pragma unroll
    for (int k = 0; k < 4; ++k) wg[(gd * 64 + gdk4 + k) * 16 + gr] = gl[1][k];
    if (F.tid < 128) bg[F.tid] = bgv;
    float k1[4] = {bf2f(kA.x & 0xffffu), bf2f(kA.x >> 16), bf2f(kA.y & 0xffffu), bf2f(kA.y >> 16)}, k2[4] = {bf2f(kB.x & 0xffffu), bf2f(kB.x >> 16), bf2f(kB.y & 0xffffu), bf2f(kB.y >> 16)};
    float q1[4] = {bf2f(qA.x & 0xffffu), bf2f(qA.x >> 16), bf2f(qA.y & 0xffffu), bf2f(qA.y >> 16)}, q2[4] = {bf2f(qB.x & 0xffffu), bf2f(qB.x >> 16), bf2f(qB.y & 0xffffu), bf2f(qB.y >> 16)};
    if (kk >= 4) {
        const f32x4 r0 = gl[2], r1 = gl[3]; const float cs[4] = {r0[0], r0[2], r1[0], r1[2]}, sn[4] = {r0[1], r0[3], r1[1], r1[3]};
#pragma unroll
        for (int e = 0; e < 4; ++e) { const float ka = k1[e] * cs[e] - k2[e] * sn[e], kb = k1[e] * sn[e] + k2[e] * cs[e]; k1[e] = ka; k2[e] = kb;
            const float qa = q1[e] * cs[e] - q2[e] * sn[e], qb = q1[e] * sn[e] + q2[e] * cs[e]; q1[e] = qa; q2[e] = qb; } }
    __syncthreads();
    { const int d = F.wave >> 2, nb = F.wave & 3, fr = F.lane & 15, fq = F.lane >> 4;
        bf16x8 wb;
        { f32x4 w0 = (f32x4){0.f, 0.f, 0.f, 0.f}, w1 = w0;
            if ((fq >> 1) == d) { const LAS float* wp = wg + (d * 64 + 16 * nb + fr) * 16 + 8 * (fq & 1); w0 = *(const LAS f32x4*)wp; w1 = *(const LAS f32x4*)(wp + 4); }
            u32x4 pw; pw.x = pk2(w0[0], w0[1]); pw.y = pk2(w0[2], w0[3]); pw.z = pk2(w1[0], w1[1]); pw.w = pk2(w1[2], w1[3]); wb = __builtin_bit_cast(bf16x8, pw); }
        const float bias = bg[d * 64 + 16 * nb + fr];
        f32x4 za0[4], za1[4];
#pragma unroll
        for (int it = 0; it < 4; ++it) { const int p = 16 * it + fr, tok = d == 0 ? p : 63 - p; const LAS float* zp = zs + tok * ZP + 8 * fq; za0[it] = *(const LAS f32x4*)zp; za1[it] = *(const LAS f32x4*)(zp + 4); }
        float carry = 0.f;
#pragma unroll
        for (int it = 0; it < 4; ++it) {
            u32x4 pz; pz.x = pk2(za0[it][0], za0[it][1]); pz.y = pk2(za0[it][2], za0[it][3]); pz.z = pk2(za1[it][0], za1[it][1]); pz.w = pk2(za1[it][2], za1[it][3]);
            f32x4 acc = (f32x4){bias, bias, bias, bias};
            acc = __builtin_amdgcn_mfma_f32_16x16x32_bf16(__builtin_bit_cast(bf16x8, pz), wb, acc, 0, 0, 0);
            float v0 = logsigmoid_fast(acc[0]) * (1.0f / 16.0f), v1 = logsigmoid_fast(acc[1]) * (1.0f / 16.0f), v2 = logsigmoid_fast(acc[2]) * (1.0f / 16.0f), v3 = logsigmoid_fast(acc[3]) * (1.0f / 16.0f);
            v1 += v0; v2 += v1; v3 += v2;
            const float t1 = __shfl_up(v3, 16), t2 = __shfl_up(v3, 32), t3 = __shfl_up(v3, 48);
            const float off = carry + (fq >= 1 ? t1 : 0.f) + (fq >= 2 ? t2 : 0.f) + (fq >= 3 ? t3 : 0.f);
            v0 += off; v1 += off; v2 += off; v3 += off;
            carry = __shfl(v3, 48 + fr);
            const float vv[4] = {v0, v1, v2, v3};
#pragma unroll
            for (int j = 0; j < 4; ++j) { const int p = 16 * it + 4 * fq + j, ti = d == 0 ? p : 63 - p; Bc[(d * 64 + ti) * 65 + 16 * nb + fr] = vv[j]; } } }
    __syncthreads();
    { const unsigned vAw[2] = {vA.x, vA.y}, vBw[2] = {vB.x, vB.y};
#pragma unroll
        for (int e = 0; e < 4; ++e) { VT[(d0 + e) * GP + i] = (bf16_t)((e & 1) ? (vAw[e >> 1] >> 16) : (vAw[e >> 1] & 0xffffu)); VT[(d0 + 16 + e) * GP + i] = (bf16_t)((e & 1) ? (vBw[e >> 1] >> 16) : (vBw[e >> 1] & 0xffffu)); }
#pragma unroll
        for (int d = 0; d < 2; ++d) { const int il = d == 0 ? 63 : 0;
            float qa[4], qb[4], ka[4], kb[4];
#pragma unroll
            for (int e = 0; e < 4; ++e) { const float b1 = Bc[(d * 64 + i) * 65 + d0 + e], b2 = Bc[(d * 64 + i) * 65 + d0 + 16 + e];
                const float l1 = Bc[(d * 64 + il) * 65 + d0 + e], l2 = Bc[(d * 64 + il) * 65 + d0 + 16 + e];
                const float e1 = __expf(b1), e2 = __expf(b2);
                qa[e] = q1[e] * 0.125f * e1; qb[e] = q2[e] * 0.125f * e2; ka[e] = k1[e] * __expf(-b1); kb[e] = k2[e] * __expf(-b2);
                KE[(d * 64 + d0 + e) * GP + i] = (bf16_t)f2bf(k1[e] * __expf(l1 - b1)); KE[(d * 64 + d0 + 16 + e) * GP + i] = (bf16_t)f2bf(k2[e] * __expf(l2 - b2)); }
            u32x2 w; w.x = pk2(qa[0], qa[1]); w.y = pk2(qa[2], qa[3]); *(LAS u32x2*)(QI + (d * 64 + i) * GP + d0) = w;
            w.x = pk2(qb[0], qb[1]); w.y = pk2(qb[2], qb[3]); *(LAS u32x2*)(QI + (d * 64 + i) * GP + d0 + 16) = w;
            w.x = pk2(ka[0], ka[1]); w.y = pk2(ka[2], ka[3]); *(LAS u32x2*)(KI + (d * 64 + i) * GP + d0) = w;
            w.x = pk2(kb[0], kb[1]); w.y = pk2(kb[2], kb[3]); *(LAS u32x2*)(KI + (d * 64 + i) * GP + d0 + 16) = w; } }
    __syncthreads();
    const int d = F.wave >> 2, t4 = F.wave & 3, fr = F.lane & 15, fq = F.lane >> 4;
    const size_t ci = ((size_t)(d * 2 + b) * 4 + h) * NCH + kk;
    const size_t cj = ((size_t)b * NCH + kk) * 4 + h;
    {
        bf16_t* KVp = (bf16_t*)(F.ws + WS_KV) + ci * 4096;
        const LAS bf16_t* ap = KE + (d * 64 + 16 * t4 + fr) * GP + 8 * fq;
        const bf16x8 k0 = *(const LAS bf16x8*)ap, k1f = *(const LAS bf16x8*)(ap + 32);
#pragma unroll
        for (int nt = 0; nt < 4; ++nt) { const LAS bf16_t* bp = VT + (16 * nt + fr) * GP + 8 * fq;
            f32x4 acc = (f32x4){0.f, 0.f, 0.f, 0.f};
            acc = __builtin_amdgcn_mfma_f32_16x16x32_bf16(k0, *(const LAS bf16x8*)bp, acc, 0, 0, 0);
            acc = __builtin_amdgcn_mfma_f32_16x16x32_bf16(k1f, *(const LAS bf16x8*)(bp + 32), acc, 0, 0, 0);
            u32x2 w; w.x = pk2(acc[0], acc[1]); w.y = pk2(acc[2], acc[3]);
            *(u32x2*)(KVp + (16 * nt + fr) * 64 + 16 * t4 + 4 * fq) = w; } }
    if (F.tid < 128) { const int dd = F.tid >> 6, dk = F.tid & 63; const size_t c2 = ((size_t)(dd * 2 + b) * 4 + h) * NCH + kk;
        ((float*)(F.ws + WS_DEC))[c2 * 64 + dk] = expf(Bc[(dd * 64 + (dd == 0 ? 63 : 0)) * 65 + dk]); }
    if (!want_o) { __syncthreads(); return; }
    f32x4 O[4];
    { const int it = t4; const LAS bf16_t* qp = QI + (d * 64 + 16 * it + fr) * GP + 8 * fq;
        const bf16x8 q0 = *(const LAS bf16x8*)qp, q1f = *(const LAS bf16x8*)(qp + 32);
        { bf16_t* qg = (bf16_t*)(F.ws + WS_QIG) + (((cj * 2 + d) * 4 + it) * 64 + F.lane) * 16; *(bf16x8*)qg = q0; *(bf16x8*)(qg + 8) = q1f; }
        const int ig = 16 * it + fr;
        bf16x8 pf[2];
#pragma unroll
        for (int s = 0; s < 2; ++s) { f32x4 at[2];
#pragma unroll
            for (int t = 0; t < 2; ++t) { const int jrow = 32 * s + 8 * (fr >> 2) + (fr & 3) + 4 * t;
                const LAS bf16_t* kp = KI + (d * 64 + jrow) * GP + 8 * fq;
                f32x4 acc = (f32x4){0.f, 0.f, 0.f, 0.f};
                acc = __builtin_amdgcn_mfma_f32_16x16x32_bf16(*(const LAS bf16x8*)kp, q0, acc, 0, 0, 0);
                acc = __builtin_amdgcn_mfma_f32_16x16x32_bf16(*(const LAS bf16x8*)(kp + 32), q1f, acc, 0, 0, 0);
#pragma unroll
                for (int j = 0; j < 4; ++j) { const int jj = 32 * s + 8 * fq + 4 * t + j; const bool ok = d == 0 ? (jj <= ig) : (jj >= ig); acc[j] = ok ? acc[j] : 0.f; }
                at[t] = acc; }
            u32x4 pw; pw.x = pg8::cvt_pk_bf16(at[0][0], at[0][1]); pw.y = pg8::cvt_pk_bf16(at[0][2], at[0][3]); pw.z = pg8::cvt_pk_bf16(at[1][0], at[1][1]); pw.w = pg8::cvt_pk_bf16(at[1][2], at[1][3]);
            pf[s] = __builtin_bit_cast(bf16x8, pw); }
#pragma unroll
        for (int dt = 0; dt < 4; ++dt) { f32x4 acc = (f32x4){0.f, 0.f, 0.f, 0.f};
            const LAS bf16_t* vp = VT + (16 * dt + fr) * GP + 8 * fq;
            acc = __builtin_amdgcn_mfma_f32_16x16x32_bf16(*(const LAS bf16x8*)vp, pf[0], acc, 0, 0, 0);
            acc = __builtin_amdgcn_mfma_f32_16x16x32_bf16(*(const LAS bf16x8*)(vp + 32), pf[1], acc, 0, 0, 0);
            O[dt] = acc; } }
    LAS float* om = OM + (t4 * 64 + F.lane) * 16;
    if (d == 1) {
#pragma unroll
        for (int dt = 0; dt < 4; ++dt) *(LAS f32x4*)(om + 4 * dt) = O[dt]; }
    __syncthreads();
    if (d == 0) { bf16_t* og = (bf16_t*)(F.ws + WS_OI) + ((cj * 4 + t4) * 64 + F.lane) * 16;
        u32x4 w0, w1; f32x4 s0 = O[0] + *(const LAS f32x4*)(om + 0), s1 = O[1] + *(const LAS f32x4*)(om + 4), s2 = O[2] + *(const LAS f32x4*)(om + 8), s3 = O[3] + *(const LAS f32x4*)(om + 12);
        w0.x = pk2(s0[0], s0[1]); w0.y = pk2(s0[2], s0[3]); w0.z = pk2(s1[0], s1[1]); w0.w = pk2(s1[2], s1[3]);
        w1.x = pk2(s2[0], s2[1]); w1.y = pk2(s2[2], s2[3]); w1.z = pk2(s3[0], s3[1]); w1.w = pk2(s3[2], s3[3]);
        *(u32x4*)og = w0; *(u32x4*)(og + 8) = w1; }
    __syncthreads();
}
__device__ __forceinline__ void t_gla_fin(Frame& F, const Args& A, int l, int task, bool need_ctx) {
    const int h = task & 3, kk = (task >> 2) % NCH, b = task / (4 * NCH);
    if (kk < 4 && !need_ctx) return;
    const int row0 = chunk_row0(b, kk);
    LAS float* OM = (LAS float*)F.lds;
    const int d = F.wave >> 2, it = F.wave & 3, fr = F.lane & 15, fq = F.lane >> 4;
    const size_t ci = ((size_t)(d * 2 + b) * 4 + h) * NCH + kk, cj = ((size_t)b * NCH + kk) * 4 + h;
    const bf16_t* qg = (const bf16_t*)(F.ws + WS_QIG) + (((cj * 2 + d) * 4 + it) * 64 + F.lane) * 16;
    const bf16x8 q0 = *(const bf16x8*)qg, q1 = *(const bf16x8*)(qg + 8);
    const bf16_t* Sp = (const bf16_t*)(F.ws + WS_SS) + ci * 4096;
    f32x4 oi[4];
    const int row = row0 + 16 * it + fr;
    u32x2 gw[4];
    if (d == 0) { const float* og = (const float*)(F.ws + WS_OI) + ((cj * 4 + it) * 64 + F.lane) * 16;
        const bf16_t* ogate = (const bf16_t*)(F.ws + WS_P) + (size_t)row * PC + C_OG + h * 64 + 4 * fq;
#pragma unroll
        for (int dt = 0; dt < 4; ++dt) { oi[dt] = *(const f32x4*)(og + 4 * dt); gw[dt] = *(const u32x2*)(ogate + 16 * dt); } }
    f32x4 O[4];
    bf16x8 sv[8];
#pragma unroll
    for (int dt = 0; dt < 4; ++dt) { const bf16_t* sp = Sp + (16 * dt + fr) * 64 + 8 * fq; sv[dt * 2] = *(const bf16x8*)sp; sv[dt * 2 + 1] = *(const bf16x8*)(sp + 32); }
    asm volatile("" : "+v"(sv[0]), "+v"(sv[1]), "+v"(sv[2]), "+v"(sv[3]), "+v"(sv[4]), "+v"(sv[5]), "+v"(sv[6]), "+v"(sv[7]) :: "memory");
#pragma unroll
    for (int dt = 0; dt < 4; ++dt) { f32x4 acc = (f32x4){0.f, 0.f, 0.f, 0.f};
        acc = __builtin_amdgcn_mfma_f32_16x16x32_bf16(sv[dt * 2], q0, acc, 0, 0, 0);
        acc = __builtin_amdgcn_mfma_f32_16x16x32_bf16(sv[dt * 2 + 1], q1, acc, 0, 0, 0);
        O[dt] = acc; }
    LAS float* om = OM + (it * 64 + F.lane) * 16;
    if (d == 1) {
#pragma unroll
        for (int dt = 0; dt < 4; ++dt) *(LAS f32x4*)(om + 4 * dt) = O[dt]; }
    __syncthreads();
    if (d == 0) {
        float sq = 0.f;
#pragma unroll
        for (int dt = 0; dt < 4; ++dt) { O[dt] = O[dt] + *(const LAS f32x4*)(om + 4 * dt) + oi[dt]; sq += (O[dt][0] * O[dt][0] + O[dt][1] * O[dt][1]) + (O[dt][2] * O[dt][2] + O[dt][3] * O[dt][3]); }
        sq += __shfl_xor(sq, 16); sq += __shfl_xor(sq, 32);
        const float rstd = __builtin_amdgcn_rsqf(sq * (1.0f / 64.0f) + EPS);
        const float* gn = INP(I_GNG) + l * 64 + 4 * fq;
        bf16_t* mo = (bf16_t*)(F.ws + WS_MIX) + (size_t)row * D + h * 64 + 4 * fq;
#pragma unroll
        for (int dt = 0; dt < 4; ++dt) { const f32x4 g4 = *(const f32x4*)(gn + 16 * dt);
            const float o0 = O[dt][0] * rstd * g4[0] * silu_fast(bf2f(gw[dt].x & 0xffffu)), o1 = O[dt][1] * rstd * g4[1] * silu_fast(bf2f(gw[dt].x >> 16));
            const float o2 = O[dt][2] * rstd * g4[2] * silu_fast(bf2f(gw[dt].y & 0xffffu)), o3 = O[dt][3] * rstd * g4[3] * silu_fast(bf2f(gw[dt].y >> 16));
            u32x2 w; w.x = pk2(o0, o1); w.y = pk2(o2, o3);
            *(u32x2*)(mo + 16 * dt) = w; }
    }
    __syncthreads();
}


__device__ __forceinline__ void t_gla_fin_wave(Frame& F, const Args& A, int l, int wt, bool need_ctx) {
    const int it = wt & 3, h = (wt >> 2) & 3, kk = (wt >> 4) % NCH, b = wt / (16 * NCH);
    if (kk < 4 && !need_ctx) return;
    const int row0 = chunk_row0(b, kk), fr = F.lane & 15, fq = F.lane >> 4;
    const size_t cj = ((size_t)b * NCH + kk) * 4 + h;
    const int row = row0 + 16 * it + fr;
    f32x4 O[4]; u32x2 gw[4]; bf16x8 qf[4], sv[16]; f32x4 g4[4];
    { const float* gn = INP(I_GNG) + l * 64 + 4 * fq;
#pragma unroll
        for (int dt = 0; dt < 4; ++dt) g4[dt] = *(const f32x4*)(gn + 16 * dt); }
    u32x4 oraw[2];
    { const bf16_t* og = (const bf16_t*)(F.ws + WS_OI) + ((cj * 4 + it) * 64 + F.lane) * 16;
        const bf16_t* ogate = (const bf16_t*)(F.ws + WS_P) + (size_t)row * PC + C_OG + h * 64 + 4 * fq;
        oraw[0] = *(const u32x4*)og; oraw[1] = *(const u32x4*)(og + 8);
#pragma unroll
        for (int dt = 0; dt < 4; ++dt) gw[dt] = *(const u32x2*)(ogate + 16 * dt); }
#pragma unroll
    for (int d = 0; d < 2; ++d) { const size_t ci = ((size_t)(d * 2 + b) * 4 + h) * NCH + kk;
        const bf16_t* qg = (const bf16_t*)(F.ws + WS_QIG) + (((cj * 2 + d) * 4 + it) * 64 + F.lane) * 16;
        qf[d * 2] = *(const bf16x8*)qg; qf[d * 2 + 1] = *(const bf16x8*)(qg + 8);
        const bf16_t* Sp = (const bf16_t*)(F.ws + WS_SS) + ci * 4096;
#pragma unroll
        for (int dt = 0; dt < 4; ++dt) { const bf16_t* sp = Sp + (16 * dt + fr) * 64 + 8 * fq; sv[d * 8 + dt * 2] = *(const bf16x8*)sp; sv[d * 8 + dt * 2 + 1] = *(const bf16x8*)(sp + 32); } }
    asm volatile("" : "+v"(sv[0]), "+v"(sv[1]), "+v"(sv[2]), "+v"(sv[3]), "+v"(sv[4]), "+v"(sv[5]), "+v"(sv[6]), "+v"(sv[7]),
                      "+v"(sv[8]), "+v"(sv[9]), "+v"(sv[10]), "+v"(sv[11]), "+v"(sv[12]), "+v"(sv[13]), "+v"(sv[14]), "+v"(sv[15]) :: "memory");
    asm volatile("" : "+v"(oraw[0]), "+v"(oraw[1]) :: "memory");
    O[0] = (f32x4){bf2f(oraw[0].x & 0xffffu), bf2f(oraw[0].x >> 16), bf2f(oraw[0].y & 0xffffu), bf2f(oraw[0].y >> 16)};
    O[1] = (f32x4){bf2f(oraw[0].z & 0xffffu), bf2f(oraw[0].z >> 16), bf2f(oraw[0].w & 0xffffu), bf2f(oraw[0].w >> 16)};
    O[2] = (f32x4){bf2f(oraw[1].x & 0xffffu), bf2f(oraw[1].x >> 16), bf2f(oraw[1].y & 0xffffu), bf2f(oraw[1].y >> 16)};
    O[3] = (f32x4){bf2f(oraw[1].z & 0xffffu), bf2f(oraw[1].z >> 16), bf2f(oraw[1].w & 0xffffu), bf2f(oraw[1].w >> 16)};
    asm volatile("" : "+v"(qf[0]), "+v"(qf[1]), "+v"(qf[2]), "+v"(qf[3]), "+v"(O[0]), "+v"(O[1]), "+v"(O[2]), "+v"(O[3]), "+v"(g4[0]), "+v"(g4[1]), "+v"(g4[2]), "+v"(g4[3]), "+v"(gw[0]), "+v"(gw[1]), "+v"(gw[2]), "+v"(gw[3]));
#pragma unroll
    for (int d = 0; d < 2; ++d)
#pragma unroll
        for (int dt = 0; dt < 4; ++dt) {
            O[dt] = __builtin_amdgcn_mfma_f32_16x16x32_bf16(sv[d * 8 + dt * 2], qf[d * 2], O[dt], 0, 0, 0);
            O[dt] = __builtin_amdgcn_mfma_f32_16x16x32_bf16(sv[d * 8 + dt * 2 + 1], qf[d * 2 + 1], O[dt], 0, 0, 0); }
    float sq = 0.f;
#pragma unroll
    for (int dt = 0; dt < 4; ++dt) sq += (O[dt][0] * O[dt][0] + O[dt][1] * O[dt][1]) + (O[dt][2] * O[dt][2] + O[dt][3] * O[dt][3]);
    sq += __shfl_xor(sq, 16); sq += __shfl_xor(sq, 32);
    const float rstd = __builtin_amdgcn_rsqf(sq * (1.0f / 64.0f) + EPS);
    bf16_t* mo = (bf16_t*)(F.ws + WS_MIX) + (size_t)row * D + h * 64 + 4 * fq;
#pragma unroll
    for (int dt = 0; dt < 4; ++dt) {
        const float o0 = O[dt][0] * rstd * g4[dt][0] * silu_fast(bf2f(gw[dt].x & 0xffffu)), o1 = O[dt][1] * rstd * g4[dt][1] * silu_fast(bf2f(gw[dt].x >> 16));
        const float o2 = O[dt][2] * rstd * g4[dt][2] * silu_fast(bf2f(gw[dt].y & 0xffffu)), o3 = O[dt][3] * rstd * g4[dt][3] * silu_fast(bf2f(gw[dt].y >> 16));
        u32x2 w; w.x = pk2(o0, o1); w.y = pk2(o2, o3);
        *(u32x2*)(mo + 16 * dt) = w; }
}

__device__ __forceinline__ void t_gmlp_mfma(Frame& F, const Args& A, int l, int task, bool need_ctx) {
    const int g = task & 3, cq = task >> 2;
    if (cq >= 128 && !need_ctx) return;
    const int row0 = cq < 128 ? (cq >> 6) * SEQ + (cq & 63) * 128 : NLAT + ((cq - 128) >> 1) * CTX + ((cq - 128) & 1) * 128;
    const bf16_t* P = (const bf16_t*)(F.ws + WS_P);
    constexpr int WP = 136;
    LAS bf16_t* W16 = (LAS bf16_t*)F.lds;
    LAS bf16_t* VNT = W16 + 128 * WP;
    LAS float* rs = (LAS float*)(VNT + 64 * WP);
    const float* gnorm = INP(I_MNG) + l * 256;
    const int fr = F.lane & 15, fq = F.lane >> 4, itok = 16 * F.wave + fr;
    const int jp = F.tid >> 3, c = F.tid & 7, j = 2 * jp;
    u32x2 rw[16]; u32x4 wv[4]; u32x4 vv[2]; f32x4 gq[2]; u32x2 gwv[4]; float bsv;
#pragma unroll
    for (int u = 0; u < 16; ++u) rw[u] = *(const u32x2*)(P + (size_t)(row0 + F.wave * 16 + u) * PC + C_GV + 4 * F.lane);
    const bf16_t* wsrc = (const bf16_t*)(F.ws + WS_MWS) + (size_t)(l * 4 + g) * 128 * 128;
#pragma unroll
    for (int u = 0; u < 4; ++u) { const int idx = F.tid + 512 * u, i = idx >> 4, j8 = (idx & 15) * 8; wv[u] = *(const u32x4*)(wsrc + i * 128 + j8); }
    { const bf16_t* vp = P + (size_t)(row0 + j) * PC + C_GV + g * 64 + 8 * c; vv[0] = *(const u32x4*)vp; vv[1] = *(const u32x4*)(vp + PC); }
    gq[0] = *(const f32x4*)(gnorm + g * 64 + 8 * c); gq[1] = *(const f32x4*)(gnorm + g * 64 + 8 * c + 4);
    const bf16_t* gu = P + (size_t)(row0 + itok) * PC + C_GU + g * 64 + 4 * fq;
#pragma unroll
    for (int dt = 0; dt < 4; ++dt) gwv[dt] = *(const u32x2*)(gu + 16 * dt);
    bsv = INP(I_MBS)[(size_t)(l * 4 + g) * 128 + itok];
    pin16(rw); pin4(wv); pin2(vv); pin2(gq); pin4(gwv); pin1(bsv);
#pragma unroll
    for (int u = 0; u < 16; ++u) { const u32x2 w = rw[u];
        const float a = bf2f(w.x & 0xffffu), b2 = bf2f(w.x >> 16), c2 = bf2f(w.y & 0xffffu), d2 = bf2f(w.y >> 16);
        const float ssum = wave_sum(a * a + b2 * b2 + c2 * c2 + d2 * d2);
        if (F.lane == 0) rs[F.wave * 16 + u] = __builtin_amdgcn_rsqf(ssum * (1.0f / 256.0f) + EPS);
    }
    {
#pragma unroll
        for (int u = 0; u < 4; ++u) { const int idx = F.tid + 512 * u, i = idx >> 4, j8 = (idx & 15) * 8; *(LAS u32x4*)(W16 + i * WP + j8) = wv[u]; } }
    __syncthreads();
    { const u32x4 v0 = vv[0], v1 = vv[1];
        const float r0 = rs[j], r1 = rs[j + 1];
        const unsigned a0[4] = {v0.x, v0.y, v0.z, v0.w}, a1[4] = {v1.x, v1.y, v1.z, v1.w};
#pragma unroll
        for (int u = 0; u < 8; ++u) { const int dd = 8 * c + u; const float gn = gq[u >> 2][u & 3];
            const float x0 = bf2f((u & 1) ? (a0[u >> 1] >> 16) : (a0[u >> 1] & 0xffffu)) * r0 * gn, x1 = bf2f((u & 1) ? (a1[u >> 1] >> 16) : (a1[u >> 1] & 0xffffu)) * r1 * gn;
            *(LAS unsigned*)(VNT + dd * WP + j) = pk2(x0, x1); } }
    __syncthreads();
    bf16x8 bw[4];
#pragma unroll
    for (int ks = 0; ks < 4; ++ks) bw[ks] = *(const LAS bf16x8*)(W16 + itok * WP + 8 * fq + 32 * ks);
    bf16_t* mo = (bf16_t*)(F.ws + WS_MIX) + (size_t)(row0 + itok) * D + 256 + g * 64 + 4 * fq;
#pragma unroll
    for (int dt = 0; dt < 4; ++dt) { f32x4 acc = (f32x4){0.f, 0.f, 0.f, 0.f};
#pragma unroll
        for (int ks = 0; ks < 4; ++ks) acc = __builtin_amdgcn_mfma_f32_16x16x32_bf16(*(const LAS bf16x8*)(VNT + (16 * dt + fr) * WP + 8 * fq + 32 * ks), bw[ks], acc, 0, 0, 0);
        const u32x2 gw = gwv[dt];
        u32x2 w; w.x = pk2(bf2f(gw.x & 0xffffu) * (acc[0] + bsv), bf2f(gw.x >> 16) * (acc[1] + bsv)); w.y = pk2(bf2f(gw.y & 0xffffu) * (acc[2] + bsv), bf2f(gw.y >> 16) * (acc[3] + bsv));
        *(u32x2*)(mo + 16 * dt) = w; }
    __syncthreads();
}

__device__ __forceinline__ int lru_task_row0(int task, int& s, int& ch, int& len, int& b, int& kk) {
    if (task < 256) { b = task >> 7; ch = task & 127; s = b; len = SEQ; kk = 4 + ch; return b * SEQ + ch * 64; }
    const int q = task - 256; b = q >> 2; ch = q & 3; s = 2 + b; len = CTX; kk = ch; return NLAT + b * CTX + ch * 64;
}
__device__ __forceinline__ void t_lru_half(Frame& F, const Args& A, int l, int task) {
    const int ch2 = task & 1; int s, ch, len, b, kk; const int row0 = lru_task_row0(task >> 1, s, ch, len, b, kk);
    const bf16_t* P = (const bf16_t*)(F.ws + WS_P);
    constexpr int XP = 136;
    LAS bf16_t* xcb = (LAS bf16_t*)F.lds;
    constexpr int ABP = 132;
    LAS float* ab = (LAS float*)(F.lds + 64 * XP * 2);
    const int cbase = 128 * ch2;
    const float* cw = INP(I_LCW) + (size_t)l * 4 * 256 + cbase; const float* cb = INP(I_LCB) + (size_t)l * 256 + cbase;
    const int d = F.wave >> 2, g2 = (F.wave >> 1) & 1, tt2 = F.wave & 1, g = 2 * ch2 + g2, fr = F.lane & 15, fq = F.lane >> 4;
    const bf16_t* WT = (const bf16_t*)(F.ws + WS_LRUW);
    f32x2 cwv[5]; float gc[12];
    bf16x8 wf[16];
    LAS bf16_t* xin = (LAS bf16_t*)(F.lds + 85504);
    { u32x4 xr[3];
#pragma unroll
        for (int u = 0; u < 3; ++u) { const int q = F.tid + 512 * u, rowi = q >> 4, c8 = (q & 15) * 8, tt = ch * 64 + rowi - 2; xr[u] = (u32x4){0u, 0u, 0u, 0u};
            if (q < 67 * 16 && tt >= 0 && tt < len) xr[u] = *(const u32x4*)(P + (size_t)(row0 + rowi - 2) * PC + C_LX + cbase + c8); }
        { const int c = (F.tid & 63) * 2; cwv[0] = *(const f32x2*)(cb + c);
#pragma unroll
            for (int j = 0; j < 4; ++j) cwv[1 + j] = *(const f32x2*)(cw + j * 256 + c); }
        { const float* pbr = INP(I_LBR) + (size_t)(l * 2 + d) * 256 + 64 * g + fr; const float* pbi = INP(I_LBI) + (size_t)(l * 2 + d) * 256 + 64 * g + fr; const float* plm = INP(I_LLAM) + (size_t)(l * 2 + d) * 256 + 64 * g + fr;
#pragma unroll
            for (int nt = 0; nt < 4; ++nt) { gc[nt] = pbr[16 * nt]; gc[4 + nt] = pbi[16 * nt]; gc[8 + nt] = plm[16 * nt]; } }
#pragma unroll
        for (int nt = 0; nt < 4; ++nt) {
            const bf16_t* wr = WT + ((size_t)(((l * 2 + d) * 2 + 0) * 4 + g) * 64 + 16 * nt + fr) * 64 + 8 * fq;
            const bf16_t* wi = WT + ((size_t)(((l * 2 + d) * 2 + 1) * 4 + g) * 64 + 16 * nt + fr) * 64 + 8 * fq;
            wf[nt * 4 + 0] = *(const bf16x8*)wr; wf[nt * 4 + 1] = *(const bf16x8*)(wr + 32); wf[nt * 4 + 2] = *(const bf16x8*)wi; wf[nt * 4 + 3] = *(const bf16x8*)(wi + 32); }
        asm volatile("" : "+v"(xr[0]), "+v"(xr[1]), "+v"(xr[2]) :: "memory");
#pragma unroll
        for (int u = 0; u < 3; ++u) { const int q = F.tid + 512 * u, rowi = q >> 4, c8 = (q & 15) * 8; if (q < 67 * 16) *(LAS u32x4*)(xin + rowi * 128 + c8) = xr[u]; }
        asm volatile("" : "+v"(cwv[0]), "+v"(cwv[1]), "+v"(cwv[2]), "+v"(cwv[3]), "+v"(cwv[4]) :: "memory");
        pin12(gc);
        __syncthreads();
#pragma unroll
        for (int u = 0; u < 8; ++u) { const int idx = F.tid + 512 * u, t = idx >> 6, c = (idx & 63) * 2; float a0 = cwv[0][0], a1 = cwv[0][1];
            unsigned w[4];
#pragma unroll
            for (int j = 0; j < 4; ++j) w[j] = *(const LAS unsigned*)(xin + (t + j) * 128 + c);
#pragma unroll
            for (int j = 0; j < 4; ++j) { a0 += cwv[1 + j][0] * bf2f(w[j] & 0xffffu); a1 += cwv[1 + j][1] * bf2f(w[j] >> 16); }
            *(LAS unsigned*)(xcb + t * XP + c) = pk2(a0, a1); } }
    float br[4], bi[4], sp[4];
#pragma unroll
    for (int nt = 0; nt < 4; ++nt) { br[nt] = gc[nt]; bi[nt] = gc[4 + nt];
        { const float xl = -gc[8 + nt]; sp[nt] = fmaxf(xl, 0.f) + ln_1to2(1.0f + __expf(-fabsf(xl))); } }
    const int sd = F.tid >> 7, sc = F.tid & 127;
    float hcur = 0.f, pa = 1.f;
    asm volatile("" : "+v"(wf[0]), "+v"(wf[1]), "+v"(wf[2]), "+v"(wf[3]), "+v"(wf[4]), "+v"(wf[5]), "+v"(wf[6]), "+v"(wf[7]),
                      "+v"(wf[8]), "+v"(wf[9]), "+v"(wf[10]), "+v"(wf[11]), "+v"(wf[12]), "+v"(wf[13]), "+v"(wf[14]), "+v"(wf[15]) :: "memory");
    __syncthreads();
    for (int hf = 0; hf < 2; ++hf) {
        { const int t0 = (d == 0 ? hf : 1 - hf) * 32;
            const LAS bf16_t* ap = xcb + (t0 + 16 * tt2 + fr) * XP + 64 * g2 + 8 * fq;
            const bf16x8 a0 = *(const LAS bf16x8*)ap, a1 = *(const LAS bf16x8*)(ap + 32);
            unsigned xw[16];
#pragma unroll
            for (int u = 0; u < 16; ++u) xw[u] = xcb[(t0 + 16 * tt2 + 4 * fq + (u & 3)) * XP + 64 * g2 + 16 * (u >> 2) + fr];
            pin16(xw);
#pragma unroll
            for (int nt = 0; nt < 4; ++nt) {
                f32x4 ar = (f32x4){0.f, 0.f, 0.f, 0.f}, ai = ar;
                ar = __builtin_amdgcn_mfma_f32_16x16x32_bf16(a0, wf[nt * 4 + 0], ar, 0, 0, 0);
                ar = __builtin_amdgcn_mfma_f32_16x16x32_bf16(a1, wf[nt * 4 + 1], ar, 0, 0, 0);
                ai = __builtin_amdgcn_mfma_f32_16x16x32_bf16(a0, wf[nt * 4 + 2], ai, 0, 0, 0);
                ai = __builtin_amdgcn_mfma_f32_16x16x32_bf16(a1, wf[nt * 4 + 3], ai, 0, 0, 0);
                const int ccl = 64 * g2 + 16 * nt + fr;
#pragma unroll
                for (int j = 0; j < 4; ++j) { const int tl = 16 * tt2 + 4 * fq + j;
                    const float dr = 1.0f + __expf(fminf(-(ar[j] + br[nt]), 40.0f)), di = 1.0f + __expf(fminf(-(ai[j] + bi[nt]), 40.0f));
                    const float inv = __builtin_amdgcn_rcpf(dr * di), r = di * inv, ig = dr * inv;
                    const float log_a = -8.0f * r * sp[nt], av = __expf(log_a), x2 = 2.0f * log_a;
                    const float om = x2 > -0.03f ? -x2 * (1.0f + x2 * (0.5f + x2 * (1.0f / 6.0f))) : 1.0f - av * av;
                    const float xv = bf2f(xw[nt * 4 + j]);
                    ab[((d * 2 + 0) * 32 + tl) * ABP + ccl] = av; ab[((d * 2 + 1) * 32 + tl) * ABP + ccl] = __builtin_amdgcn_sqrtf(om) * (ig * xv); } } }
        __syncthreads();
        if (F.tid < 256) { const int st0 = (sd == 0 ? hf : 1 - hf) * 32;
            bf16_t* LH = (bf16_t*)(F.ws + WS_LH) + (size_t)sd * MROWS * 256 + cbase + sc; bf16_t* LA = (bf16_t*)(F.ws + WS_LA) + (size_t)sd * MROWS * 256 + cbase + sc;
#pragma unroll 1
            for (int n0 = 0; n0 < 32; n0 += 8) {
                float avs[16];
#pragma unroll
                for (int u = 0; u < 8; ++u) { const int tl = sd == 0 ? n0 + u : 31 - (n0 + u); avs[u] = ab[((sd * 2 + 0) * 32 + tl) * ABP + sc]; avs[8 + u] = ab[((sd * 2 + 1) * 32 + tl) * ABP + sc]; }
                pin16(avs);
#pragma unroll
                for (int u = 0; u < 8; ++u) { const int tl = sd == 0 ? n0 + u : 31 - (n0 + u);
                    hcur = avs[u] * hcur + avs[8 + u]; pa *= avs[u];
                    LH[(size_t)(row0 + st0 + tl) * 256] = (bf16_t)f2bf(hcur); LA[(size_t)(row0 + st0 + tl) * 256] = (bf16_t)f2bf(pa); } } }
        __syncthreads();
    }
    if (F.tid < 256) { const size_t si = ((size_t)(sd * 2 + b) * NCH + kk) * 256 + cbase + sc;
        ((float*)(F.ws + WS_LSA))[si] = pa; ((float*)(F.ws + WS_LSH))[si] = hcur; }
    __syncthreads();
}
__device__ __forceinline__ void t_lru_scan_e(Frame& F, int e, bool dry);
__device__ __forceinline__ void t_lru_scan(Frame& F, int task, bool dry = false) { t_lru_scan_e(F, task * 512 + F.tid, dry); }
__device__ __forceinline__ void t_lru_scan_e(Frame& F, int e, bool dry) {
    const int c = e & 255, db = e >> 8, d = db >> 1;
    const float* SA = (const float*)(F.ws + WS_LSA) + (size_t)db * NCH * 256 + c; const float* SH = (const float*)(F.ws + WS_LSH) + (size_t)db * NCH * 256 + c;
    float* LC = (float*)(F.ws + WS_LC) + (size_t)db * NCH * 256 + c;
    float hc = 0.f;
    for (int n0 = 0; n0 < NCH; n0 += 22) {
        float a[22], hh[22]; int idx[22];
#pragma unroll
        for (int u = 0; u < 22; ++u) { const int n = n0 + u; idx[u] = d == 0 ? n : (n < 4 ? 3 - n : NCH - 1 - (n - 4)); a[u] = SA[idx[u] * 256]; hh[u] = SH[idx[u] * 256]; }
#pragma unroll
        for (int u = 0; u < 22; ++u) { (dry ? LC + (WS_HID - WS_LC) / 4 : LC)[idx[u] * 256] = hc; hc = a[u] * hc + hh[u]; }
    }
}
__device__ __forceinline__ void t_lru_fix(Frame& F, int task, bool need_ctx) {
    int s, ch, len, b, kk; const int row0 = lru_task_row0(task, s, ch, len, b, kk);
    if (task >= 256 && !need_ctx) return;
    const bf16_t* P = (const bf16_t*)(F.ws + WS_P);
    const bf16_t* LH = (const bf16_t*)(F.ws + WS_LH); const bf16_t* LA = (const bf16_t*)(F.ws + WS_LA); const float* LC = (const float*)(F.ws + WS_LC);
    bf16_t* MIX = (bf16_t*)(F.ws + WS_MIX);
    const bf16_t* LH1 = LH + (size_t)MROWS * 256; const bf16_t* LA1 = LA + (size_t)MROWS * 256;
    const float* c0p = LC + ((size_t)(0 * 2 + b) * NCH + kk) * 256; const float* c1p = LC + ((size_t)(1 * 2 + b) * NCH + kk) * 256;
#pragma unroll 1
    for (int half = 0; half < 2; ++half) {
        u32x2 h0[4], a0[4], h1[4], a1[4]; f32x4 r0[4], r1[4]; u32x2 yw[4];
#pragma unroll
        for (int u = 0; u < 4; ++u) { const int idx = F.tid + 512 * (half * 4 + u), t = idx >> 6, c4 = (idx & 63) * 4; const size_t ro = (size_t)(row0 + t) * 256 + c4;
            h0[u] = *(const u32x2*)(LH + ro); a0[u] = *(const u32x2*)(LA + ro); h1[u] = *(const u32x2*)(LH1 + ro); a1[u] = *(const u32x2*)(LA1 + ro);
            r0[u] = *(const f32x4*)(c0p + c4); r1[u] = *(const f32x4*)(c1p + c4); yw[u] = *(const u32x2*)(P + (size_t)(row0 + t) * PC + C_LY + c4); }
        asm volatile("" : "+v"(h0[0]), "+v"(h0[1]), "+v"(h0[2]), "+v"(h0[3]), "+v"(a0[0]), "+v"(a0[1]), "+v"(a0[2]), "+v"(a0[3]),
                          "+v"(h1[0]), "+v"(h1[1]), "+v"(h1[2]), "+v"(h1[3]), "+v"(a1[0]), "+v"(a1[1]), "+v"(a1[2]), "+v"(a1[3]) :: "memory");
#pragma unroll
        for (int u = 0; u < 4; ++u) { const int idx = F.tid + 512 * (half * 4 + u), t = idx >> 6, c4 = (idx & 63) * 4;
            const f32x4 H0 = (f32x4){bf2f(h0[u].x & 0xffffu), bf2f(h0[u].x >> 16), bf2f(h0[u].y & 0xffffu), bf2f(h0[u].y >> 16)}, A0 = (f32x4){bf2f(a0[u].x & 0xffffu), bf2f(a0[u].x >> 16), bf2f(a0[u].y & 0xffffu), bf2f(a0[u].y >> 16)};
            const f32x4 H1 = (f32x4){bf2f(h1[u].x & 0xffffu), bf2f(h1[u].x >> 16), bf2f(h1[u].y & 0xffffu), bf2f(h1[u].y >> 16)}, A1 = (f32x4){bf2f(a1[u].x & 0xffffu), bf2f(a1[u].x >> 16), bf2f(a1[u].y & 0xffffu), bf2f(a1[u].y >> 16)};
            const f32x4 hs = (H0 + A0 * r0[u]) + (H1 + A1 * r1[u]);
            const float y0 = bf2f(yw[u].x & 0xffffu), y1 = bf2f(yw[u].x >> 16), y2 = bf2f(yw[u].y & 0xffffu), y3 = bf2f(yw[u].y >> 16);
            u32x2 o; o.x = pk2(hs[0] * gelu_tanh(y0), hs[1] * gelu_tanh(y1)); o.y = pk2(hs[2] * gelu_tanh(y2), hs[3] * gelu_tanh(y3));
            *(u32x2*)(MIX + (size_t)(row0 + t) * D + 512 + c4) = o; }
    }
}


__device__ __forceinline__ void t_nat_mfma(Frame& F, const Args& A, int l, int task, bool need_ctx) {
    const bool isctx = task >= 1024;
    if (isctx && !need_ctx) return;
    int b, r, h, qrow0;
    if (!isctx) { h = task & 3; r = (task >> 2) & 127; b = task >> 9; qrow0 = b * SEQ + r * 64; }
    else { const int q = task - 1024; h = q & 3; r = (q >> 2) & 3; b = q >> 4; qrow0 = NLAT + b * CTX + r * 64; }
    const bf16_t* P = (const bf16_t*)(F.ws + WS_P);
    constexpr int VP = 776;
    LAS unsigned* VT32 = (LAS unsigned*)F.lds;
    LAS float* rp = (LAS float*)(F.lds + 64 * VP * 2);
    LAS float* mg = rp + 512;
    constexpr int KP = 72;
    LAS bf16_t* KC = (LAS bf16_t*)(mg + 4 * 64 * 18);
    const int crow0 = NLAT + b * CTX;
    const int r0 = r - 4 < 0 ? 0 : (r - 4 > 120 ? 120 : r - 4);
    const int n = F.wave & 3, half = F.wave >> 2, fr = F.lane & 15, g = F.lane >> 4;
    const int band0 = n == 0 ? 0 : (n == 1 ? 8 : (n == 2 ? 24 : 32));
    const int qcol = 16 * n + fr, c0q = qcol - 8 < 0 ? 0 : (qcol - 8 > 48 ? 48 : qcol - 8);
    const bool active = !(isctx && half == 0);
    const int koff = 8 * (fr >> 2) + (fr & 3);
    bf16x8 q0, q1, kfa[16], kfb[16];
    { u32x4 va[6], vb[6], kc[4]; float rpv = 0.f;
#pragma unroll
        for (int u = 0; u < 6; ++u) { const int it = F.tid + 512 * u, c = it & 7, kp = it >> 3, k0 = 2 * kp;
            if (isctx && u < 4) continue;
            const int row = k0 < 512 ? b * SEQ + (r0 + (k0 >> 6)) * 64 + (k0 & 63) : crow0 + (k0 - 512);
            const bf16_t* vp = P + (size_t)row * PC + C_NV + h * 64 + 8 * c;
            va[u] = *(const u32x4*)vp; vb[u] = *(const u32x4*)(vp + PC); }
#pragma unroll
        for (int u = 0; u < 4; ++u) { const int idx = F.tid + 512 * u, key = idx >> 3, c = idx & 7; kc[u] = *(const u32x4*)(P + (size_t)(crow0 + key) * PC + C_NK + h * 64 + 8 * c); }
        if (!isctx && F.tid < 15 * 31) rpv = INP(I_RPB)[(size_t)(l * 4 + h) * 15 * 31 + F.tid];
        if (active) { const bf16_t* qp = P + (size_t)(qrow0 + 16 * n + fr) * PC + C_NQ + h * 64 + 8 * g; q0 = *(const bf16x8*)qp; q1 = *(const bf16x8*)(qp + 32); }
        if (active && half == 0) {
#pragma unroll
            for (int s = 0; s < 4; ++s)
#pragma unroll
                for (int t = 0; t < 2; ++t) { const bf16_t* kp = P + (size_t)(b * SEQ + (r0 + s) * 64 + band0 + koff + 4 * t) * PC + C_NK + h * 64 + 8 * g;
                    kfa[(s * 2 + t) * 2] = *(const bf16x8*)kp; kfa[(s * 2 + t) * 2 + 1] = *(const bf16x8*)(kp + 32); } }
        asm volatile("" ::: "memory");
        if (!isctx) asm volatile("" : "+v"(va[0]), "+v"(va[1]), "+v"(va[2]), "+v"(va[3]), "+v"(vb[0]), "+v"(vb[1]), "+v"(vb[2]), "+v"(vb[3]) :: "memory");
        asm volatile("" : "+v"(va[4]), "+v"(va[5]), "+v"(vb[4]), "+v"(vb[5]) :: "memory");
#pragma unroll
        for (int u = 0; u < 6; ++u) { const int it = F.tid + 512 * u, c = it & 7, kp = it >> 3;
            if (isctx && u < 4) continue;
            const u32x4 v0 = va[u], v1 = vb[u];
            LAS unsigned* dst = VT32 + (8 * c) * (VP / 2) + (kp ^ (8 * (c >> 1)));
            dst[0 * (VP / 2)] = (v0.x & 0xffffu) | (v1.x << 16); dst[1 * (VP / 2)] = (v0.x >> 16) | (v1.x & 0xffff0000u);
            dst[2 * (VP / 2)] = (v0.y & 0xffffu) | (v1.y << 16); dst[3 * (VP / 2)] = (v0.y >> 16) | (v1.y & 0xffff0000u);
            dst[4 * (VP / 2)] = (v0.z & 0xffffu) | (v1.z << 16); dst[5 * (VP / 2)] = (v0.z >> 16) | (v1.z & 0xffff0000u);
            dst[6 * (VP / 2)] = (v0.w & 0xffffu) | (v1.w << 16); dst[7 * (VP / 2)] = (v0.w >> 16) | (v1.w & 0xffff0000u); }
        pin4(kc);
#pragma unroll
        for (int u = 0; u < 4; ++u) { const int idx = F.tid + 512 * u, key = idx >> 3, c = idx & 7; *(LAS u32x4*)(KC + key * KP + 8 * c) = kc[u]; }
        if (!isctx && F.tid < 15 * 31) rp[F.tid] = rpv * 1.4426950408889634f;
        if (active && half == 0) {
#pragma unroll
            for (int s = 4; s < 8; ++s)
#pragma unroll
                for (int t = 0; t < 2; ++t) { const bf16_t* kp = P + (size_t)(b * SEQ + (r0 + s) * 64 + band0 + koff + 4 * t) * PC + C_NK + h * 64 + 8 * g;
                    kfb[((s - 4) * 2 + t) * 2] = *(const bf16x8*)kp; kfb[((s - 4) * 2 + t) * 2 + 1] = *(const bf16x8*)(kp + 32); } }
        asm volatile("" ::: "memory"); }
    __syncthreads();
    f32x4 S[8][2];
    float mx = -1e30f, sum = 0.f;
    f32x4 O[4];
#pragma unroll
    for (int dt = 0; dt < 4; ++dt) O[dt] = (f32x4){0.f, 0.f, 0.f, 0.f};
    if (active) {
        if (half == 1) {
#pragma unroll
            for (int s = 0; s < 8; ++s)
#pragma unroll
                for (int t = 0; t < 2; ++t) { const LAS bf16_t* kp = KC + (32 * s + koff + 4 * t) * KP + 8 * g; const bf16x8 f0 = *(const LAS bf16x8*)kp, f1 = *(const LAS bf16x8*)(kp + 32);
                    f32x4 acc = (f32x4){0.f, 0.f, 0.f, 0.f};
                    acc = __builtin_amdgcn_mfma_f32_16x16x32_bf16(f0, q0, acc, 0, 0, 0);
                    acc = __builtin_amdgcn_mfma_f32_16x16x32_bf16(f1, q1, acc, 0, 0, 0);
                    S[s][t] = acc; }
        } else {
            asm volatile("" : "+v"(kfa[0]), "+v"(kfa[1]), "+v"(kfa[2]), "+v"(kfa[3]), "+v"(kfa[4]), "+v"(kfa[5]), "+v"(kfa[6]), "+v"(kfa[7]),
                              "+v"(kfa[8]), "+v"(kfa[9]), "+v"(kfa[10]), "+v"(kfa[11]), "+v"(kfa[12]), "+v"(kfa[13]), "+v"(kfa[14]), "+v"(kfa[15]) :: "memory");
#pragma unroll
            for (int s = 0; s < 4; ++s)
#pragma unroll
                for (int t = 0; t < 2; ++t) { f32x4 acc = (f32x4){0.f, 0.f, 0.f, 0.f};
                    acc = __builtin_amdgcn_mfma_f32_16x16x32_bf16(kfa[(s * 2 + t) * 2], q0, acc, 0, 0, 0);
                    acc = __builtin_amdgcn_mfma_f32_16x16x32_bf16(kfa[(s * 2 + t) * 2 + 1], q1, acc, 0, 0, 0);
                    S[s][t] = acc; }
            asm volatile("" : "+v"(kfb[0]), "+v"(kfb[1]), "+v"(kfb[2]), "+v"(kfb[3]), "+v"(kfb[4]), "+v"(kfb[5]), "+v"(kfb[6]), "+v"(kfb[7]),
                              "+v"(kfb[8]), "+v"(kfb[9]), "+v"(kfb[10]), "+v"(kfb[11]), "+v"(kfb[12]), "+v"(kfb[13]), "+v"(kfb[14]), "+v"(kfb[15]) :: "memory");
#pragma unroll
            for (int s = 4; s < 8; ++s)
#pragma unroll
                for (int t = 0; t < 2; ++t) { f32x4 acc = (f32x4){0.f, 0.f, 0.f, 0.f};
                    acc = __builtin_amdgcn_mfma_f32_16x16x32_bf16(kfb[((s - 4) * 2 + t) * 2], q0, acc, 0, 0, 0);
                    acc = __builtin_amdgcn_mfma_f32_16x16x32_bf16(kfb[((s - 4) * 2 + t) * 2 + 1], q1, acc, 0, 0, 0);
                    S[s][t] = acc; }
        }
        if (half == 0) {
#pragma unroll
            for (int s2 = 0; s2 < 8; s2 += 2) { float bz[16];
                const LAS float* rpb = rp + (r0 + s2 - r + 7) * 31 + (band0 + 8 * g - qcol + 15);
#pragma unroll
                for (int u = 0; u < 16; ++u) bz[u] = rpb[(u >> 3) * 31 + (u & 7)];
                pin16(bz);
#pragma unroll
                for (int u = 0; u < 16; ++u) { const int s = s2 + (u >> 3), t = (u >> 2) & 1, j = u & 3, kcol = band0 + 8 * g + (u & 7); const bool valid = kcol >= c0q && kcol < c0q + 16;
                    const float v = valid ? __builtin_fmaf(S[s][t][j], 0.125f * 1.4426950408889634f, bz[u]) : -1e30f;
                    S[s][t][j] = v; mx = fmaxf(mx, v); } }
        } else {
#pragma unroll
            for (int s = 0; s < 8; ++s)
#pragma unroll
                for (int t = 0; t < 2; ++t)
#pragma unroll
                    for (int j = 0; j < 4; ++j) { const float v = S[s][t][j] * (0.125f * 1.4426950408889634f); S[s][t][j] = v; mx = fmaxf(mx, v); }
        }
        mx = fmaxf(mx, __shfl_xor(mx, 16)); mx = fmaxf(mx, __shfl_xor(mx, 32));
#pragma unroll
        for (int s = 0; s < 8; ++s)
#pragma unroll
            for (int t = 0; t < 2; ++t)
#pragma unroll
                for (int j = 0; j < 4; ++j) { const float p = __builtin_amdgcn_exp2f(S[s][t][j] - mx); S[s][t][j] = p; sum += p; }
        sum += __shfl_xor(sum, 16); sum += __shfl_xor(sum, 32);
        const LAS bf16_t* VT = (const LAS bf16_t*)F.lds;
#pragma unroll
        for (int s = 0; s < 8; ++s) {
            u32x4 pw; pw.x = pg8::cvt_pk_bf16(S[s][0][0], S[s][0][1]); pw.y = pg8::cvt_pk_bf16(S[s][0][2], S[s][0][3]);
            pw.z = pg8::cvt_pk_bf16(S[s][1][0], S[s][1][1]); pw.w = pg8::cvt_pk_bf16(S[s][1][2], S[s][1][3]);
            const bf16x8 pf = __builtin_bit_cast(bf16x8, pw);
            const int kbase = (half == 0 ? s * 64 + band0 : 512 + 32 * s) + 8 * g;
#pragma unroll
            for (int dt = 0; dt < 4; ++dt) { const bf16x8 vf = *(const LAS bf16x8*)(VT + (16 * dt + fr) * VP + (kbase ^ (16 * dt)));
                O[dt] = __builtin_amdgcn_mfma_f32_16x16x32_bf16(vf, pf, O[dt], 0, 0, 0); } }
    }
    LAS float* mrow = mg + ((size_t)(n * 64 + F.lane)) * 18;
    if (half == 1) { mrow[0] = mx; mrow[1] = sum;
#pragma unroll
        for (int dt = 0; dt < 4; ++dt)
#pragma unroll
            for (int j = 0; j < 4; ++j) mrow[2 + dt * 4 + j] = O[dt][j]; }
    __syncthreads();
    if (half == 0) {
        const float m1 = mrow[0], s1 = mrow[1];
        const float M = fmaxf(mx, m1), a0 = __builtin_amdgcn_exp2f(mx - M), a1 = __builtin_amdgcn_exp2f(m1 - M);
        const float inv = 1.0f / (sum * a0 + s1 * a1);
        bf16_t* mo = (bf16_t*)(F.ws + WS_MIX) + (size_t)(qrow0 + 16 * n + fr) * D + 768 + h * 64 + 4 * g;
#pragma unroll
        for (int dt = 0; dt < 4; ++dt) { float o[4];
#pragma unroll
            for (int j = 0; j < 4; ++j) o[j] = (O[dt][j] * a0 + mrow[2 + dt * 4 + j] * a1) * inv;
            u32x2 w; w.x = pk2(o[0], o[1]); w.y = pk2(o[2], o[3]);
            *(u32x2*)(mo + 16 * dt) = w; }
    }
    __syncthreads();
}

__device__ __forceinline__ void p5_norm2_router(Frame& F, const Args& A, int l, bool need_ctx) {
    LAS float* wrt = (LAS float*)F.lds;
    LAS float* sc = wrt + 16 * D;
    LAS float* sh = sc + 3 * D;
    LAS float* ng = sh + 3 * D;
    const float* mod = (const float*)(F.ws + WS_MOD) + (size_t)l * 3 * 6144;
    { const float* wsrc = INP(I_WROUT) + (size_t)l * D * 16;
        f32x4 t[8], m[4]; f32x4 gq = (f32x4){0.f, 0.f, 0.f, 0.f};
#pragma unroll
        for (int u = 0; u < 8; ++u) t[u] = *(const f32x4*)(wsrc + 4 * (F.tid + 512 * u));
#pragma unroll
        for (int u = 0; u < 2; ++u) { const int i4 = F.tid + 512 * u, i = 4 * i4, s = i >> 10, j = i & 1023; m[2 * u] = (f32x4){0.f, 0.f, 0.f, 0.f}; m[2 * u + 1] = m[2 * u];
            if (i4 < 768) { m[2 * u] = *(const f32x4*)(mod + s * 6144 + 3072 + j); m[2 * u + 1] = *(const f32x4*)(mod + s * 6144 + 4096 + j); } }
        if (F.tid < 256) gq = *(const f32x4*)(INP(I_N2G) + l * D + 4 * F.tid);
        pin8(t); pin4(m); pin1(gq);
#pragma unroll
        for (int u = 0; u < 8; ++u) { const int i = 4 * (F.tid + 512 * u), c = i >> 4, e = i & 15;
#pragma unroll
            for (int k = 0; k < 4; ++k) wrt[(e + k) * D + c] = t[u][k]; }
#pragma unroll
        for (int u = 0; u < 2; ++u) { const int i4 = F.tid + 512 * u, i = 4 * i4;
            if (i4 < 768) { *(LAS f32x4*)(sh + i) = m[2 * u]; *(LAS f32x4*)(sc + i) = m[2 * u + 1] + 1.0f; } }
        if (F.tid < 256) *(LAS f32x4*)(ng + 4 * F.tid) = gq; }
    __syncthreads();
    const bf16_t* X = (const bf16_t*)(F.ws + WS_X); bf16_t* H = (bf16_t*)(F.ws + WS_H); float* AFF = (float*)(F.ws + WS_AFF);
    const int nrows = need_ctx ? MROWS : NLAT;
    static_assert(CB_P5 >= CV_IN + CV_OUT && CB_DRAIN <= CV_PER_L, "ride-along conversion range");
    const bool cvt_on = need_ctx && F.G == 256;
    LAS float* cscr = (LAS float*)(F.lds + (16 * D + 7 * D) * 4) + F.wave * (64 * 33);
    int krow = 0;
    u32x2 pv[4];
#pragma unroll
    for (int j = 0; j < 4; ++j) pv[j] = (u32x2){0u, 0u};
    if (F.gw < nrows) {
#pragma unroll
        for (int j = 0; j < 4; ++j) pv[j] = *(const u32x2*)(X + (size_t)F.gw * D + 4 * F.lane + 256 * j); }
    for (int row = F.gw; row < nrows; row += F.NGW, ++krow) {
        const int set = row_set(row), ms = set < 2 ? set : 2, tok = row - set_base(set);
        const bool docv = cvt_on && krow < CQ5;
        CvtDesc cd; f32x4 cv[8];
        if (docv) { cd = cvt_decode_moe(F, A, l + 1, CB_P5 + krow * F.NGW + F.gw);
#pragma unroll
            for (int i = 0; i < 8; ++i) { const int kk = 8 * i + (F.lane >> 3), nn = (F.lane & 7) * 4; cv[i] = __builtin_nontemporal_load((const f32x4*)(cd.W + (size_t)(cd.k0 + kk) * cd.N + cd.n0 + nn)); }
            asm volatile("" ::: "memory"); }
        f32x4 v[4]; float ss = 0.f;
#pragma unroll
        for (int j = 0; j < 4; ++j) { v[j] = (f32x4){__uint_as_float(pv[j].x << 16), __uint_as_float(pv[j].x & 0xffff0000u), __uint_as_float(pv[j].y << 16), __uint_as_float(pv[j].y & 0xffff0000u)}; ss += (v[j][0] * v[j][0] + v[j][1] * v[j][1]) + (v[j][2] * v[j][2] + v[j][3] * v[j][3]); }
        if (row + F.NGW < nrows) {
#pragma unroll
            for (int j = 0; j < 4; ++j) pv[j] = *(const u32x2*)(X + (size_t)(row + F.NGW) * D + 4 * F.lane + 256 * j); }
        const float rstd = __builtin_amdgcn_rsqf(wave_sum(ss) * (1.0f / D) + EPS);
#pragma unroll
        for (int j = 0; j < 4; ++j) { const int c0 = 4 * F.lane + 256 * j;
            const f32x4 gn = *(const LAS f32x4*)(ng + c0), s1 = *(const LAS f32x4*)(sc + ms * D + c0), h1 = *(const LAS f32x4*)(sh + ms * D + c0);
            v[j] = v[j] * rstd * gn * s1 + h1;
            u32x2 w; w.x = pg8::cvt_pk_bf16(v[j][0], v[j][1]); w.y = pg8::cvt_pk_bf16(v[j][2], v[j][3]);
            *(u32x2*)(H + (size_t)row * D + c0) = w; }
        float mine = 0.f;
#pragma unroll
        for (int e4 = 0; e4 < 16; e4 += 4) {
            f32x4 wq[16];
#pragma unroll
            for (int u = 0; u < 16; ++u) wq[u] = *(const LAS f32x4*)(wrt + (e4 + (u >> 2)) * D + 4 * F.lane + 256 * (u & 3));
            pin16(wq);
#pragma unroll
            for (int ee = 0; ee < 4; ++ee) { float a = 0.f;
#pragma unroll
                for (int j = 0; j < 4; ++j) { const f32x4 w = wq[ee * 4 + j]; a += v[j][0] * w[0] + v[j][1] * w[1] + v[j][2] * w[2] + v[j][3] * w[3]; }
                a += __int_as_float(__builtin_amdgcn_update_dpp(0, __float_as_int(a), 0xB1, 0xf, 0xf, true));
                a += __int_as_float(__builtin_amdgcn_update_dpp(0, __float_as_int(a), 0x4E, 0xf, 0xf, true));
                a += __int_as_float(__builtin_amdgcn_update_dpp(0, __float_as_int(a), 0x124, 0xf, 0xf, true));
                a += __int_as_float(__builtin_amdgcn_update_dpp(0, __float_as_int(a), 0x128, 0xf, 0xf, true));
                mine = ((F.lane & 15) == e4 + ee) ? a : mine; } }
        mine += __shfl_xor(mine, 16); mine += __shfl_xor(mine, 32);
        float mx = mine;
        mx = fmaxf(mx, __int_as_float(__builtin_amdgcn_update_dpp(0, __float_as_int(mx), 0xB1, 0xf, 0xf, true)));
        mx = fmaxf(mx, __int_as_float(__builtin_amdgcn_update_dpp(0, __float_as_int(mx), 0x4E, 0xf, 0xf, true)));
        mx = fmaxf(mx, __int_as_float(__builtin_amdgcn_update_dpp(0, __float_as_int(mx), 0x124, 0xf, 0xf, true)));
        mx = fmaxf(mx, __int_as_float(__builtin_amdgcn_update_dpp(0, __float_as_int(mx), 0x128, 0xf, 0xf, true)));
        const float pe = expf(mine - mx);
        float sum = pe;
        sum += __int_as_float(__builtin_amdgcn_update_dpp(0, __float_as_int(sum), 0xB1, 0xf, 0xf, true));
        sum += __int_as_float(__builtin_amdgcn_update_dpp(0, __float_as_int(sum), 0x4E, 0xf, 0xf, true));
        sum += __int_as_float(__builtin_amdgcn_update_dpp(0, __float_as_int(sum), 0x124, 0xf, 0xf, true));
        sum += __int_as_float(__builtin_amdgcn_update_dpp(0, __float_as_int(sum), 0x128, 0xf, 0xf, true));
        if (F.lane < 16) { const float p = pe / sum;
            if (set < 2) AFF[((size_t)set * NE + F.lane) * SEQ + tok] = p; else AFF[(size_t)2 * NE * SEQ + ((size_t)(set - 2) * NE + F.lane) * CTX + tok] = p; }
        if (docv) {
#pragma unroll
            for (int i = 0; i < 8; ++i) { const int kk = 8 * i + (F.lane >> 3), nn = (F.lane & 7) * 4; LAS float* sp = cscr + kk * 33 + nn; sp[0] = cv[i][0]; sp[1] = cv[i][1]; sp[2] = cv[i][2]; sp[3] = cv[i][3]; }
            LDS_WAIT();
            const int c = F.lane & 7;
#pragma unroll
            for (int j = 0; j < 4; ++j) { const int n = (F.lane >> 3) + 8 * j; const LAS float* sp = cscr + (8 * c) * 33 + n;
                u32x4 o; o.x = pk2(sp[0 * 33], sp[1 * 33]); o.y = pk2(sp[2 * 33], sp[3 * 33]); o.z = pk2(sp[4 * 33], sp[5 * 33]); o.w = pk2(sp[6 * 33], sp[7 * 33]);
                __builtin_nontemporal_store(o, (u32x4*)(cd.WT + (cd.dr + n) * (size_t)cd.K + cd.k0 + 8 * c)); }
            LDS_WAIT(); }
    }
}

template <int N, int TPT, int CAP>
__device__ __forceinline__ void select_set(Frame& F, const float* aff, int* slot_out, int xs_row0, int h_row0, int part, int nparts) {
    LAS unsigned* keys = (LAS unsigned*)F.lds;
    LAS unsigned* hist = keys + N;
    LAS unsigned* ctl = hist + 256;
    LAS unsigned* wtot = ctl + 8;
    LAS int* glist = (LAS int*)(wtot + 16);
    { constexpr int NL = N / 512 > 0 ? N / 512 : 1; float av[NL];
#pragma unroll
        for (int u = 0; u < NL; ++u) av[u] = (F.tid + 512 * u < N) ? aff[F.tid + 512 * u] : 0.f;
#pragma unroll
        for (int u = 0; u < NL; ++u) if (F.tid + 512 * u < N) keys[F.tid + 512 * u] = __float_as_uint(av[u]); }
    __syncthreads();
    unsigned kreg[TPT];
#pragma unroll
    for (int u = 0; u < TPT; ++u) kreg[u] = F.tid * TPT < N ? keys[F.tid * TPT + u] : 0u;
    LAS unsigned* cnt = hist;
    unsigned T = 0u;
    for (int bit = 29; bit >= 0; --bit) {
        const unsigned cand = T | (1u << bit);
        unsigned c = 0;
#pragma unroll
        for (int u = 0; u < TPT; ++u) c += (unsigned)__builtin_popcountll(__ballot(kreg[u] >= cand));
        LAS unsigned* cb = cnt + (bit & 1) * 8;
        if (F.lane == 0) cb[F.wave] = c;
        __syncthreads();
        unsigned tot = 0;
#pragma unroll
        for (int w = 0; w < 8; ++w) tot += cb[w];
        if (tot >= (unsigned)CAP) T = cand;
    }
    unsigned need_eq;
    { unsigned c = 0;
#pragma unroll
        for (int u = 0; u < TPT; ++u) c += (unsigned)__builtin_popcountll(__ballot(kreg[u] > T));
        __syncthreads();
        if (F.lane == 0) cnt[F.wave] = c;
        __syncthreads();
        unsigned tot = 0;
#pragma unroll
        for (int w = 0; w < 8; ++w) tot += cnt[w];
        need_eq = (unsigned)CAP - tot; }
    __syncthreads();
    unsigned cg = 0, ce = 0;
    if (F.tid * TPT < N) {
#pragma unroll
        for (int u = 0; u < TPT; ++u) { const unsigned k = keys[F.tid * TPT + u]; cg += k > T; ce += k == T; } }
    unsigned pk = cg | (ce << 16), inc = pk;
#pragma unroll
    for (int o = 1; o < 64; o <<= 1) { const unsigned t = __shfl_up(inc, o); if (F.lane >= o) inc += t; }
    if (F.lane == 63) wtot[F.wave] = inc;
    __syncthreads();
    unsigned base = 0;
    for (int w = 0; w < F.wave; ++w) base += wtot[w];
    unsigned exc = base + inc - pk;
    unsigned g_before = exc & 0xffffu, e_before = exc >> 16;
    const int per = N / nparts, lo = part * per, hi = lo + per;
    if (F.tid * TPT == lo) ctl[2] = g_before + (e_before < need_eq ? e_before : need_eq);
    __syncthreads();
    const unsigned part_first = ctl[2];
    if (F.tid * TPT < N && F.tid * TPT >= lo && F.tid * TPT < hi) {
#pragma unroll
        for (int u = 0; u < TPT; ++u) { const int tok = F.tid * TPT + u; const unsigned k = keys[tok];
            int sl = -1;
            if (k > T) { sl = (int)(g_before + (e_before < need_eq ? e_before : need_eq)); ++g_before; }
            else if (k == T) { if (e_before < need_eq) sl = (int)(g_before + e_before); ++e_before; }
            slot_out[tok] = sl;
            if (sl >= 0) { ((int*)(F.ws + WS_XS))[xs_row0 + sl] = h_row0 + tok; ((float*)(F.ws + WS_GSEL))[xs_row0 + sl] = __uint_as_float(k); } }
    }
    __syncthreads();
}
__device__ __forceinline__ void p6_select(Frame& F, bool need_ctx) {
    const float* AFF = (const float*)(F.ws + WS_AFF); int* SLOT = (int*)(F.ws + WS_SLOT);
    const int ntask = 256 + (need_ctx ? 32 : 0);
    for (int task = F.vcu; task < ntask; task += F.G) {
        if (task < 256) { const int set = task >> 3, part = task & 7, b = set >> 4, e = set & 15;
            select_set<SEQ, 16, 1024>(F, AFF + (size_t)set * SEQ, SLOT + (size_t)set * SEQ, e * XS_PER_E + b * 1024, b * SEQ, part, 8);
            (void)b; }
        else { const int set = task - 256, b = set >> 4, e = set & 15;
            select_set<CTX, 1, 32>(F, AFF + (size_t)2 * NE * SEQ + (size_t)set * CTX, SLOT + (size_t)2 * NE * SEQ + (size_t)set * CTX, e * XS_PER_E + 2048 + b * 32, NLAT + b * CTX, 0, 1); }
        __syncthreads();
    }
}

constexpr int PH_PER_L = 10, PH_FINAL = 1 + DEPTH * PH_PER_L, PH_COUNT = PH_FINAL + 1;

__global__ void __launch_bounds__(NWAVES * 64, 2) dit_fwd(Args args) {
    extern __shared__ __attribute__((aligned(16))) unsigned char lds_raw[];
    Frame F0;
    F0.lds = (LAS unsigned char*)lds_raw;
    F0.tid = threadIdx.x; F0.lane = F0.tid & 63; F0.wave = __builtin_amdgcn_readfirstlane(F0.tid >> 6);
    F0.G = gridDim.x; F0.bx = blockIdx.x; { const int bx = blockIdx.x; F0.vcu = (F0.G % 8 == 0) ? (bx % 8) * (F0.G / 8) + bx / 8 : bx; }
    F0.gw = F0.vcu * NWAVES + F0.wave; F0.NGW = F0.G * NWAVES;
    F0.ws = args.ws;
    volatile LAS unsigned* misc = (volatile LAS unsigned*)(F0.lds + LDS_MISC);
    if (F0.tid < 4) misc[F0.tid] = 0u;
    __syncthreads();
#if MK_SINGLE
    XcdBarrier bar = xcd_barrier_post((unsigned*)(F0.ws + WS_CTL) + 4096, misc);
#define GRID_BAR() xcd_barrier(bar)
#else
#define GRID_BAR() do { } while (0)
#endif
    const int lo = args.ph_lo, hi = args.ph_hi;
#ifndef EN_MASK
#define EN_MASK 0xFFFF
#endif
#define EN(q) ((EN_MASK >> (q)) & 1)
#define IN(k) (lo <= (k) && (k) < hi)
#define SEAM(k) do { if (IN((k) + 1)) { GRID_BAR(); if (PROBE_BAR) GRID_BAR(); } } while (0)

    if (EN(0) && IN(0)) { for (int rep = 0; rep < REP_P0; ++rep) { Frame F = launder(F0); p0_prologue(F, args); __syncthreads(); } SEAM(0); }

    for (int l = 0; l < DEPTH; ++l) {
        const int pb = 1 + l * PH_PER_L; const bool need_ctx = l < DEPTH - 1;
        if (EN(1) && IN(pb + 0)) { if (PROBE_DRY) { Frame F = launder(F0); p1_norm1(F, args, l, true); __syncthreads(); } Frame F = launder(F0); p1_norm1(F, args, l); __syncthreads(); SEAM(pb + 0); }
        if (EN(2) && IN(pb + 1)) for (int rep = 0; rep < REP_GEMM; ++rep) { Frame F = launder(F0);
            pg8::Gemm g{(const bf16_t*)(F.ws + WS_H), (const bf16_t*)(F.ws + WS_WIN) + (size_t)l * INC * D, D};
            pg8::StaticOrder S; S.init(MROWS, PC, F.G, F.bx);
            pg8::EpiBf16 E{(bf16_t*)(F.ws + WS_P), PC};
            pg8::gemm_phase(F.lds, F.tid, g, S, E);
            p2_gate_feats(F, l);
            __syncthreads(); SEAM(pb + 1);
        }
        if (EN(3) && IN(pb + 2)) { Frame F = launder(F0);
            for (int rep = 0; rep < REP_MIX; ++rep) {
                if (F.vcu & 1) {
                    for (int t = (F.vcu + F.G - 48) % F.G; t < 1056; t += F.G) { Frame F1 = launder(F); for (int r2 = 0; r2 < REP_GLA; ++r2) t_gla_main(F1, args, l, t, need_ctx); }
                    for (int t = (F.vcu + F.G - 80) % F.G; t < 528; t += F.G) { Frame F1 = launder(F); for (int r2 = 0; r2 < REP_GMLP; ++r2) t_gmlp_mfma(F1, args, l, t, need_ctx); }
                    for (int t = F.vcu; t < 528; t += F.G) { Frame F1 = launder(F); for (int r2 = 0; r2 < REP_LRU; ++r2) t_lru_half(F1, args, l, t); }
                    for (int t = (F.vcu + F.G - 16) % F.G; t < 1056; t += F.G) { Frame F1 = launder(F); for (int r2 = 0; r2 < REP_NAT; ++r2) t_nat_mfma(F1, args, l, t, need_ctx); }
                } else {
                    for (int t = F.vcu; t < 528; t += F.G) { Frame F1 = launder(F); for (int r2 = 0; r2 < REP_LRU; ++r2) t_lru_half(F1, args, l, t); }
                    for (int t = (F.vcu + F.G - 16) % F.G; t < 1056; t += F.G) { Frame F1 = launder(F); for (int r2 = 0; r2 < REP_NAT; ++r2) t_nat_mfma(F1, args, l, t, need_ctx); }
                    for (int t = (F.vcu + F.G - 48) % F.G; t < 1056; t += F.G) { Frame F1 = launder(F); for (int r2 = 0; r2 < REP_GLA; ++r2) t_gla_main(F1, args, l, t, need_ctx); }
                    for (int t = (F.vcu + F.G - 80) % F.G; t < 528; t += F.G) { Frame F1 = launder(F); for (int r2 = 0; r2 < REP_GMLP; ++r2) t_gmlp_mfma(F1, args, l, t, need_ctx); }
                }
            }
            __syncthreads(); SEAM(pb + 2);
        }
        if (EN(4) && IN(pb + 3)) { Frame F = launder(F0);
            if (PROBE_DRY) { for (int t = F.vcu; t < 130; t += F.G) { if (t < 128) t_gla_scan(F, t, true); else t_lru_scan(F, t - 128, true); } }
            if (F.G == 256) {
                if (F.wave < 4) { for (int t = F.vcu; t < 260; t += F.G) { const int e = (t < 256 ? t : t - 256) * 256 + (F.tid & 255); if (t < 256) t_gla_scan_e(F, e); else t_lru_scan_e(F, e, false); } }
                else if (need_ctx) { LAS float* scr = (LAS float*)(F.lds) + F.wave * (64 * 33);
                    cvt_stream_moe(F, args, l + 1, CB3 + F.vcu * 4 + (F.wave - 4), CB3 + 126 * CQ3, 1024, scr); }
            } else { for (int t = F.vcu; t < 130; t += F.G) { if (t < 128) t_gla_scan(F, t); else t_lru_scan(F, t - 128); } }
            __syncthreads(); SEAM(pb + 3);
        }
        if (EN(5) && IN(pb + 4)) { Frame F = launder(F0);
            constexpr int T0 = 2 * NCH * 4, T1 = T0 + 264;
            for (int rep = 0; rep < REP_MIX; ++rep) {
                for (int wt = F.gw; wt < 2 * NCH * 16; wt += F.NGW) for (int r2 = 0; r2 < REP_GLA; ++r2) t_gla_fin_wave(F, args, l, wt, need_ctx);
                for (int t = F.vcu; t < 264; t += F.G) { Frame F1 = launder(F); for (int r2 = 0; r2 < REP_LRU; ++r2) t_lru_fix(F1, t, need_ctx); }
            }
            (void)T0; (void)T1;
            __syncthreads(); SEAM(pb + 4);
        }
        if (EN(6) && IN(pb + 5)) { Frame F = launder(F0);
            pg8::Gemm g{(const bf16_t*)(F.ws + WS_MIX), (const bf16_t*)(F.ws + WS_WOUT) + (size_t)l * D * D, D};
            pg8::StaticOrder S; S.init(need_ctx ? MROWS : NLAT, D, F.G, F.bx);
            pg8::EpiResGate E{(bf16_t*)(F.ws + WS_X), (const float*)(F.ws + WS_MOD) + (size_t)l * 3 * 6144};
            pg8::gemm_phase(F.lds, F.tid, g, S, E);
            if (need_ctx && F.G == 256 && F.bx >= 8) cvt_range(F, args, l + 1, CB4 + (F.bx - 8) * CQ4, CQ4);
            __syncthreads(); SEAM(pb + 5);
        }
        if (EN(7) && IN(pb + 6)) for (int rep = 0; rep < REP_SMALL * REP_P5; ++rep) { Frame F = launder(F0); p5_norm2_router(F, args, l, need_ctx); __syncthreads(); SEAM(pb + 6); }
        if (EN(8) && IN(pb + 7)) for (int rep = 0; rep < REP_SMALL; ++rep) { Frame F = launder(F0); p6_select(F, need_ctx); __syncthreads(); SEAM(pb + 7); }
        if (EN(9) && IN(pb + 8)) for (int rep = 0; rep < REP_GEMM; ++rep) { Frame F = launder(F0);
            pg8::Gemm g{(const bf16_t*)(F.ws + WS_H), (const bf16_t*)(F.ws + WS_W1) + (size_t)l * NE * 4096 * D, D};
            pg8::MoeOrder S; S.init(need_ctx ? 9 : 8, 16, F.G, F.vcu);
            pg8::EpiSwiglu E{(bf16_t*)(F.ws + WS_HID), FF};
            LAS int* idxl = (LAS int*)(F.lds + pg8::STAGE_BYTES);
            { const int* IDX = (const int*)(F.ws + WS_XS); pg8::Unit u;
                for (int i = 0; i < 31 && S.next(i, u); ++i) if (F.tid < 256)   { const bool pad = (u.pm % 9 == 8) && F.tid >= 64; idxl[i * 256 + F.tid] = pad ? 0 : IDX[u.pm * 256 + F.tid]; } }
            __syncthreads();
            pg8::gemm_phase_gather(F.lds, F.tid, g, S, E, idxl);
            __syncthreads(); SEAM(pb + 8);
        }
        if (EN(10) && IN(pb + 9)) for (int rep = 0; rep < REP_GEMM; ++rep) { Frame F = launder(F0);
            pg8::Gemm g{(const bf16_t*)(F.ws + WS_HID), (const bf16_t*)(F.ws + WS_W2) + (size_t)l * NE * D * FF, FF};
            pg8::MoeOrder S; S.init(need_ctx ? 9 : 8, 4, F.G, F.vcu);
            pg8::EpiBf16 E{(bf16_t*)(F.ws + WS_Y), D};
            pg8::gemm_phase(F.lds, F.tid, g, S, E);
            if (need_ctx && F.G == 256 && F.vcu >= 64) cvt_range(F, args, l + 1, CB8 + (F.vcu - 64) * CQ8, CQ8);
            __syncthreads(); SEAM(pb + 9);
        }
    }
    if (EN(1) && IN(PH_FINAL)) { if (PROBE_DRY) { Frame F = launder(F0); p1_norm1(F, args, DEPTH, true); __syncthreads(); } Frame F = launder(F0); p1_norm1(F, args, DEPTH); }
#undef IN
#undef SEAM
}

extern "C" void kernel_launch(void* const* d_in, const int* in_sizes, int n_in, void* d_out, int out_size, void* d_ws, size_t ws_size, hipStream_t stream) {
    static int grid = 0;
    if (grid == 0) {
        if (n_in != 29 || ws_size < WS_END) { fprintf(stderr, "kernel_launch: need 29 inputs and %zu bytes of workspace; got %d inputs, %zu bytes\n", (size_t)WS_END, n_in, ws_size); grid = -1; return; }
        int dev = 0, cus = 0, per_cu = 0;
        if (hipGetDevice(&dev) != hipSuccess || hipDeviceGetAttribute(&cus, hipDeviceAttributeMultiprocessorCount, dev) != hipSuccess) { grid = -1; return; }
        if (hipFuncSetAttribute((const void*)dit_fwd, hipFuncAttributeMaxDynamicSharedMemorySize, LDS_BYTES) != hipSuccess) { fprintf(stderr, "kernel_launch: hipFuncSetAttribute failed\n"); grid = -1; return; }
        if (hipOccupancyMaxActiveBlocksPerMultiprocessor(&per_cu, (const void*)dit_fwd, NWAVES * 64, LDS_BYTES) != hipSuccess || per_cu < 1) { fprintf(stderr, "kernel_launch: occupancy query says %d\n", per_cu); grid = -1; return; }
        (void)hipGetLastError();
        grid = cus;
    }
    if (grid < 0) return;
    (void)in_sizes; (void)out_size;
    (void)hipMemsetAsync((char*)d_ws + WS_CTL, 0, CTL_BYTES, stream);
    Args a{};
    for (int i = 0; i < 29; ++i) a.in[i] = (const float*)d_in[i];
    a.out = (float*)d_out; a.ws = (unsigned char*)d_ws;
#if MK_SINGLE
    a.ph_lo = 0; a.ph_hi = PH_COUNT;
    hipLaunchKernelGGL(dit_fwd, dim3(grid), dim3(NWAVES * 64), LDS_BYTES, stream, a);
#else
    for (int p = 0; p < PH_COUNT; ++p) { a.ph_lo = p; a.ph_hi = p + 1; hipLaunchKernelGGL(dit_fwd, dim3(grid), dim3(NWAVES * 64), LDS_BYTES, stream, a); }
#endif
}
```
